# Optimizing an MI355X kernel written in HIP

```python
import math
import jax, jax.numpy as jnp
from jax import lax
import numpy as np


D_MODEL = 1024
BATCH = 2
SEQ = 8192
DEPTH = 4

HEAD_DIM = 64
ROPE_THETA = 10000.0
EPS = 1e-6
A_Q_HEADS = 8
A_KV_HEADS = 2
A_GROUP = A_Q_HEADS // A_KV_HEADS
A_WIDTH = A_Q_HEADS * HEAD_DIM
A_KV_WIDTH = A_KV_HEADS * HEAD_DIM
WINDOW = 128
A_BLOCK = 128
B_HEADS = 4
B_QK_DIM = HEAD_DIM
B_V_DIM = 2 * HEAD_DIM
B_QK_WIDTH = B_HEADS * 2 * B_QK_DIM
B_WIDTH = B_HEADS * B_V_DIM
B_QBLOCK = 128
C_HEADS = 4
C_HEAD_DIM = 128
C_WIDTH = C_HEADS * C_HEAD_DIM
C_CONV = 5
C_CHUNK = 64
N_BRANCH = 3

IN_SPLITS = (A_WIDTH, A_KV_WIDTH, A_KV_WIDTH, A_WIDTH,
             B_QK_WIDTH, B_QK_WIDTH, B_WIDTH, B_WIDTH,
             3 * C_WIDTH, C_WIDTH, 2 * C_HEADS, 2 * C_HEADS,
             N_BRANCH * D_MODEL)
D_IN = sum(IN_SPLITS)

kernel_name = 'hybrid_gated_branch_encoder'


def rmsnorm(x, g):
    x32 = x.astype(jnp.float32)
    y = x32 * lax.rsqrt(jnp.mean(x32 * x32, axis=-1, keepdims=True) + EPS)
    return (y * g.astype(jnp.float32)).astype(x.dtype)


def l2norm(x):
    return x * lax.rsqrt(jnp.sum(x * x, axis=-1, keepdims=True) + EPS)


def rope_tables(seq, dim):
    inv = 1.0 / (ROPE_THETA ** (jnp.arange(0, dim, 2, dtype=jnp.float32) / dim))
    ang = jnp.arange(seq, dtype=jnp.float32)[:, None] * inv[None, :]
    return jnp.cos(ang), jnp.sin(ang)


def apply_rope(t, cos, sin):
    shape = (t.shape[1],) + (1,) * (t.ndim - 3) + (cos.shape[-1],)
    c = cos.reshape(shape)
    s = sin.reshape(shape)
    t32 = t.astype(jnp.float32)
    t1, t2 = jnp.split(t32, 2, axis=-1)
    return jnp.concatenate([t1 * c - t2 * s, t2 * c + t1 * s], axis=-1).astype(t.dtype)


def windowed_gqa(q, k, v, sink, cos, sin):
    bsz, seq = q.shape[0], q.shape[1]
    nb = seq // A_BLOCK
    q = apply_rope(q, cos, sin)
    k = apply_rope(k, cos, sin)
    qb = q.reshape(bsz, nb, A_BLOCK, A_KV_HEADS, A_GROUP, HEAD_DIM)

    def band(t):
        tb = t.reshape(bsz, nb, A_BLOCK, A_KV_HEADS, HEAD_DIM)
        tp = jnp.pad(tb, ((0, 0), (1, 1), (0, 0), (0, 0), (0, 0)))
        return jnp.concatenate([tp[:, :-2], tp[:, 1:-1], tp[:, 2:]], axis=2)

    kw, vw = band(k), band(v)
    s = jnp.einsum('bnqhgd,bnkhd->bnhgqk', qb, kw).astype(jnp.float32) * (HEAD_DIM ** -0.5)
    qpos = jnp.arange(A_BLOCK)[:, None]
    kpos = jnp.arange(3 * A_BLOCK)[None, :] - A_BLOCK
    kabs = jnp.arange(nb)[:, None, None] * A_BLOCK + kpos[None]
    valid = (jnp.abs(kpos - qpos) <= WINDOW)[None] & (kabs >= 0) & (kabs < seq)
    s = jnp.where(valid[None, :, None, None], s, -1e30)
    sink_col = jnp.broadcast_to(sink.astype(jnp.float32).reshape(1, 1, A_KV_HEADS, A_GROUP, 1, 1),
                                s.shape[:-1] + (1,))
    p = jax.nn.softmax(jnp.concatenate([s, sink_col], axis=-1), axis=-1)[..., :-1]
    o = jnp.einsum('bnhgqk,bnkhd->bnqhgd', p.astype(v.dtype), vw)
    return o.reshape(bsz, seq, A_WIDTH)


def diff_attention(q, k, v, lam, sub_g, lam_init, cos, sin):
    bsz, seq = q.shape[0], q.shape[1]
    nb = seq // B_QBLOCK
    q = apply_rope(q, cos, sin)
    k = apply_rope(k, cos, sin)
    qb = q.reshape(bsz, nb, B_QBLOCK, B_HEADS, 2, B_QK_DIM).transpose(1, 0, 2, 3, 4, 5)
    scale = B_QK_DIM ** -0.5

    def block(qi):
        s = jnp.einsum('bqhcd,bkhcd->bhcqk', qi, k).astype(jnp.float32) * scale
        p = jax.nn.softmax(s, axis=-1)
        a = p[:, :, 0] - lam * p[:, :, 1]
        return jnp.einsum('bhqk,bkhe->bqhe', a.astype(v.dtype), v)

    o = lax.map(block, qb)
    o = o.transpose(1, 0, 2, 3, 4).reshape(bsz, seq, B_HEADS, B_V_DIM)
    o = rmsnorm(o, sub_g) * (1.0 - lam_init)
    return o.reshape(bsz, seq, B_WIDTH)


def centred_short_conv(u, w):
    pad = (C_CONV - 1) // 2
    y = lax.conv_general_dilated(u, w[:, None, :].astype(u.dtype), window_strides=(1,),
                                 padding=[(pad, pad)], dimension_numbers=('NWC', 'WIO', 'NWC'),
                                 feature_group_count=u.shape[-1])
    return jax.nn.silu(y)


def gated_delta_chunked(q, k, v, g, beta):
    bsz, seq, nh, dk = q.shape
    dv = v.shape[-1]
    n = seq // C_CHUNK
    q = l2norm(q) * (dk ** -0.5)
    k = l2norm(k)

    def chunk(t):
        return t.reshape(bsz, n, C_CHUNK, nh, t.shape[-1]).transpose(0, 3, 1, 2, 4)

    qc, kc, vc = chunk(q), chunk(k), chunk(v)
    gc = jnp.cumsum(g.reshape(bsz, n, C_CHUNK, nh).transpose(0, 3, 1, 2), axis=-1)
    bc = beta.reshape(bsz, n, C_CHUNK, nh).transpose(0, 3, 1, 2)[..., None]
    tril = jnp.tril(jnp.ones((C_CHUNK, C_CHUNK), dtype=bool))
    strict = jnp.tril(jnp.ones((C_CHUNK, C_CHUNK), dtype=bool), -1)
    diff = gc[..., :, None] - gc[..., None, :]
    decay = jnp.where(tril, jnp.exp(jnp.where(tril, diff, 0.0)), 0.0)
    kb = kc * bc
    vb = vc * bc
    amat = jnp.where(strict, jnp.einsum('bhncd,bhnjd->bhncj', kb, kc) * decay, 0.0)
    eye = jnp.eye(C_CHUNK, dtype=jnp.float32)
    tmat = lax.linalg.triangular_solve(amat + eye, jnp.broadcast_to(eye, amat.shape),
                                       left_side=True, lower=True)
    u = jnp.einsum('bhncj,bhnje->bhnce', tmat, vb)
    w = jnp.einsum('bhncj,bhnjd->bhncd', tmat, kb * jnp.exp(gc)[..., None])
    attn = jnp.where(tril, jnp.einsum('bhncd,bhnjd->bhncj', qc, kc) * decay, 0.0)
    g_last = gc[..., -1]
    k_tail = kc * jnp.exp(g_last[..., None] - gc)[..., None]
    q_dec = qc * jnp.exp(gc)[..., None]

    def to_front(t):
        return jnp.moveaxis(t, 2, 0)

    xs = (to_front(q_dec), to_front(w), to_front(u), to_front(attn), to_front(k_tail), to_front(g_last))

    def step(state, inp):
        qd, wi, ui, ai, kt, gl = inp
        v_new = ui - jnp.einsum('bhcd,bhde->bhce', wi, state)
        o = jnp.einsum('bhcd,bhde->bhce', qd, state) + jnp.einsum('bhcj,bhje->bhce', ai, v_new)
        state = state * jnp.exp(gl)[..., None, None] + jnp.einsum('bhcd,bhce->bhde', kt, v_new)
        return state, o

    state0 = jnp.zeros((bsz, nh, dk, dv), dtype=jnp.float32)
    _, o = lax.scan(step, state0, xs)
    return o.transpose(1, 0, 3, 2, 4).reshape(bsz, seq, nh, dv)


def setup_inputs(seed: int = 0) -> dict:
    key = jax.random.key(seed)
    ks = jax.random.split(key, 16)
    f32 = jnp.float32
    x = jax.random.normal(ks[0], (BATCH, SEQ, D_MODEL), f32)
    norm_g = 1.0 + 0.05 * jax.random.normal(ks[1], (DEPTH, D_MODEL), f32)
    w_in = jax.random.normal(ks[2], (DEPTH, D_MODEL, D_IN), f32) * (D_MODEL ** -0.5)
    a_sink = 0.5 * jax.random.normal(ks[3], (DEPTH, A_Q_HEADS), f32)
    b_lambda = 0.1 * jax.random.normal(ks[4], (DEPTH, 4, B_QK_DIM), f32)
    b_subln_g = 1.0 + 0.05 * jax.random.normal(ks[5], (DEPTH, B_V_DIM), f32)
    c_conv_w = jax.random.normal(ks[6], (DEPTH, C_CONV, 3 * C_WIDTH), f32) * (C_CONV ** -0.5)
    c_a_log = jnp.log(jax.random.uniform(ks[7], (DEPTH, 2, C_HEADS), f32, 1.0, 16.0))
    dt = jnp.exp(jax.random.uniform(ks[8], (DEPTH, 2, C_HEADS), f32, math.log(1e-3), math.log(1e-1)))
    c_dt_bias = dt + jnp.log(-jnp.expm1(-dt))
    c_norm_g = 1.0 + 0.05 * jax.random.normal(ks[9], (DEPTH, C_HEAD_DIM), f32)
    w_bo_a = jax.random.normal(ks[10], (DEPTH, A_WIDTH, D_MODEL), f32) * (A_WIDTH ** -0.5)
    w_bo_b = jax.random.normal(ks[11], (DEPTH, B_WIDTH, D_MODEL), f32) * (B_WIDTH ** -0.5)
    w_bo_c = jax.random.normal(ks[12], (DEPTH, C_WIDTH, D_MODEL), f32) * (C_WIDTH ** -0.5)
    w_out = jax.random.normal(ks[13], (DEPTH, D_MODEL, D_MODEL), f32) * (0.5 * D_MODEL ** -0.5)
    final_g = 1.0 + 0.05 * jax.random.normal(ks[14], (D_MODEL,), f32)
    return {'x': x, 'norm_g': norm_g, 'w_in': w_in, 'a_sink': a_sink, 'b_lambda': b_lambda,
            'b_subln_g': b_subln_g, 'c_conv_w': c_conv_w, 'c_a_log': c_a_log, 'c_dt_bias': c_dt_bias,
            'c_norm_g': c_norm_g, 'w_bo_a': w_bo_a, 'w_bo_b': w_bo_b, 'w_bo_c': w_bo_c,
            'w_out': w_out, 'final_g': final_g}


def reference(x, norm_g, w_in, a_sink, b_lambda, b_subln_g, c_conv_w, c_a_log, c_dt_bias,
              c_norm_g, w_bo_a, w_bo_b, w_bo_c, w_out, final_g):
    bsz, seq = x.shape[0], x.shape[1]
    cos, sin = rope_tables(seq, HEAD_DIM)
    offsets = [int(o) for o in np.cumsum(IN_SPLITS)[:-1]]
    for l in range(DEPTH):
        h = rmsnorm(x, norm_g[l])
        proj = jnp.einsum('bsd,de->bse', h, w_in[l])
        (a_q, a_k, a_v, a_z, b_q, b_k, b_v, b_z,
         c_qkv, c_z, c_b, c_a, gate_logits) = jnp.split(proj, offsets, axis=-1)

        o_a = windowed_gqa(a_q.reshape(bsz, seq, A_Q_HEADS, HEAD_DIM),
                           a_k.reshape(bsz, seq, A_KV_HEADS, HEAD_DIM),
                           a_v.reshape(bsz, seq, A_KV_HEADS, HEAD_DIM), a_sink[l], cos, sin)
        y_a = jnp.einsum('bse,ed->bsd', o_a * jax.nn.silu(a_z), w_bo_a[l])

        lam_init = 0.8 - 0.6 * math.exp(-0.3 * l)
        lq1, lk1, lq2, lk2 = b_lambda[l].astype(jnp.float32)
        lam = jnp.exp(jnp.sum(lq1 * lk1)) - jnp.exp(jnp.sum(lq2 * lk2)) + lam_init
        o_b = diff_attention(b_q.reshape(bsz, seq, B_HEADS, 2, B_QK_DIM),
                             b_k.reshape(bsz, seq, B_HEADS, 2, B_QK_DIM),
                             b_v.reshape(bsz, seq, B_HEADS, B_V_DIM), lam, b_subln_g[l], lam_init, cos, sin)
        y_b = jnp.einsum('bse,ed->bsd', o_b * jax.nn.silu(b_z), w_bo_b[l])

        qkv = centred_short_conv(c_qkv, c_conv_w[l]).astype(jnp.float32)
        c_q, c_k, c_v = jnp.split(qkv, 3, axis=-1)
        c_q = c_q.reshape(bsz, seq, C_HEADS, C_HEAD_DIM)
        c_k = c_k.reshape(bsz, seq, C_HEADS, C_HEAD_DIM)
        c_v = c_v.reshape(bsz, seq, C_HEADS, C_HEAD_DIM)
        beta = jax.nn.sigmoid(c_b.astype(jnp.float32)).reshape(bsz, seq, 2, C_HEADS)
        g = -jnp.exp(c_a_log[l].astype(jnp.float32))[None, None] * jax.nn.softplus(
            c_a.astype(jnp.float32).reshape(bsz, seq, 2, C_HEADS) + c_dt_bias[l].astype(jnp.float32)[None, None])
        o_fwd = gated_delta_chunked(c_q, c_k, c_v, g[:, :, 0], beta[:, :, 0])
        o_bwd = jnp.flip(gated_delta_chunked(jnp.flip(c_q, 1), jnp.flip(c_k, 1), jnp.flip(c_v, 1),
                                             jnp.flip(g[:, :, 1], 1), jnp.flip(beta[:, :, 1], 1)), 1)
        o_c = rmsnorm((o_fwd + o_bwd).astype(x.dtype), c_norm_g[l]).reshape(bsz, seq, C_WIDTH)
        y_c = jnp.einsum('bse,ed->bsd', o_c * jax.nn.silu(c_z), w_bo_c[l])

        gates = jax.nn.sigmoid(gate_logits.astype(jnp.float32)).reshape(bsz, seq, N_BRANCH, D_MODEL).astype(x.dtype)
        merged = gates[:, :, 0] * y_a + gates[:, :, 1] * y_b + gates[:, :, 2] * y_c
        x = x + jnp.einsum('bsd,de->bse', merged, w_out[l])
    return rmsnorm(x, final_g)
```

```cpp
#include <hip/hip_runtime.h>
#include <hip/hip_cooperative_groups.h>
#include <stdint.h>
#include <stdio.h>
namespace cg = cooperative_groups;

#define DI __device__ __forceinline__
typedef unsigned short bf16_t;
typedef __attribute__((ext_vector_type(8))) short bf16x8;
typedef __attribute__((ext_vector_type(16))) float f32x16;
typedef __attribute__((ext_vector_type(4))) float f32x4;
typedef __attribute__((ext_vector_type(2))) unsigned u32x2;
typedef __attribute__((ext_vector_type(4))) unsigned u32x4;
typedef __bf16 bf2_t __attribute__((ext_vector_type(2)));
typedef float f2_t __attribute__((ext_vector_type(2)));

#define MFMA32(a, b, c) __builtin_amdgcn_mfma_f32_32x32x16_bf16((a), (b), (c), 0, 0, 0)
#define MFMA16(a, b, c) __builtin_amdgcn_mfma_f32_16x16x32_bf16((a), (b), (c), 0, 0, 0)

constexpr int S = 8192;
constexpr int NTOK = 16384;
constexpr int DINP = 8576;
constexpr float LOG2E = 1.4426950408889634f;
constexpr float QSCALE = 0.125f * 1.4426950408889634f;
constexpr int LDS_MAIN = 75776;
constexpr int LDS_TOTAL = LDS_MAIN + 1072;
#ifndef SLOTS
#define SLOTS 6
#endif
#ifndef DUP_K
#define DUP_K -1
#endif
#ifndef DUP_FLAGS
#define DUP_FLAGS 3
#endif
constexpr int N_PHASES = 2 + 4 * SLOTS;
#ifndef PH_MASK
#define PH_MASK 0xff
#endif

constexpr size_t MBY = 1024 * 1024;
constexpr size_t OFF_WT_IN = 0;
constexpr size_t OFF_WT_BO = OFF_WT_IN + (size_t)4 * DINP * 1024 * 2;
constexpr size_t OFF_WT_OUT = OFF_WT_BO + (size_t)12 * 1024 * 512 * 2;
constexpr size_t OFF_ROWSS = OFF_WT_OUT + (size_t)4 * 1024 * 1024 * 2;
constexpr size_t OFF_ROPEC = OFF_ROWSS + (size_t)5 * NTOK * 4;
constexpr size_t OFF_ROPES = OFF_ROPEC + (size_t)S * 32 * 4;
constexpr size_t OFF_LAM = OFF_ROPES + (size_t)S * 32 * 4;
constexpr size_t OFF_CTR = OFF_LAM + 256;
constexpr size_t OFF_EGL = OFF_CTR + 256;
constexpr size_t OFF_BAR = OFF_EGL + 8192;
constexpr size_t OFF_QCTR = OFF_BAR + 16384;
constexpr size_t OFF_XB = OFF_QCTR + 16384;
constexpr size_t OFF_QB = OFF_XB + 32 * MBY;
constexpr size_t OFF_KB = OFF_QB + 16 * MBY;
constexpr size_t OFF_VBT = OFF_KB + 16 * MBY;
constexpr size_t OFF_ZB = OFF_VBT + 16 * MBY;
constexpr size_t OFF_ZC = OFF_ZB + 16 * MBY;
constexpr size_t OFF_GATE = OFF_ZC + 16 * MBY;
constexpr size_t OFF_OA = OFF_GATE + 96 * MBY;
constexpr size_t OFF_SHORT = OFF_OA + 16 * MBY;
constexpr size_t OFF_CQD = OFF_SHORT + 89 * MBY;
constexpr size_t OFF_CW = OFF_CQD + 32 * MBY;
constexpr size_t OFF_CKT = OFF_CW + 32 * MBY;
constexpr size_t OFF_CATTN = OFF_CKT + 32 * MBY;
constexpr size_t WS_TOTAL = OFF_CATTN + 16 * MBY;
constexpr int MAX_GRID = 640;

struct Params {
  const float *x, *norm_g, *w_in, *a_sink, *b_lambda, *b_subln_g, *c_conv_w, *c_a_log, *c_dt_bias, *c_norm_g,
      *w_bo_a, *w_bo_b, *w_bo_c, *w_out, *final_g;
  float* out;
  char* ws;
  int ph0, ph1, dup_k, dup_flags;
#define WSP(name, type, off) DI type* name() const { return (type*)(ws + (off)); }
  WSP(wt_in, bf16_t, OFF_WT_IN) WSP(wt_bo, bf16_t, OFF_WT_BO) WSP(wt_out, bf16_t, OFF_WT_OUT)
  WSP(rowss, float, OFF_ROWSS) WSP(ropec, float, OFF_ROPEC) WSP(ropes, float, OFF_ROPES)
  WSP(lam, float, OFF_LAM) WSP(ctr, unsigned, OFF_CTR) WSP(c_egl, float, OFF_EGL) WSP(bar, unsigned, OFF_BAR) WSP(qctr, unsigned, OFF_QCTR)
  WSP(xb, bf16_t, OFF_XB) WSP(c_u, bf16_t, OFF_XB)
  WSP(qb, bf16_t, OFF_QB) WSP(kb, bf16_t, OFF_KB) WSP(vbt, bf16_t, OFF_VBT) WSP(zb, bf16_t, OFF_ZB)
  WSP(zc, bf16_t, OFF_ZC) WSP(gate, bf16_t, OFF_GATE) WSP(oa, bf16_t, OFF_OA)
  WSP(cqkv, bf16_t, OFF_SHORT) WSP(qa, bf16_t, OFF_SHORT + 48 * MBY) WSP(ka, bf16_t, OFF_SHORT + 64 * MBY)
  WSP(vat, bf16_t, OFF_SHORT + 68 * MBY) WSP(za, bf16_t, OFF_SHORT + 72 * MBY) WSP(betag, float, OFF_SHORT + 88 * MBY)
  WSP(ob0, bf16_t, OFF_SHORT) WSP(oc, bf16_t, OFF_SHORT + 16 * MBY) WSP(ob1, bf16_t, OFF_SHORT + 48 * MBY)
  WSP(c_qd, bf16_t, OFF_CQD) WSP(merged, bf16_t, OFF_CQD) WSP(c_w, bf16_t, OFF_CW) WSP(c_kt, bf16_t, OFF_CKT)
  WSP(c_attn, bf16_t, OFF_CATTN)
#undef WSP
};

__constant__ float kInvFreq[32] = {
    0x1.0000000000000p+0f, 0x1.7ff2220000000p-1f, 0x1.1feb340000000p-1f, 0x1.afd1360000000p-2f,
    0x1.43d1360000000p-2f, 0x1.e5a84a0000000p-3f, 0x1.6c310e0000000p-3f, 0x1.111aee0000000p-3f,
    0x1.99999a0000000p-4f, 0x1.33281a0000000p-4f, 0x1.ccab840000000p-5f, 0x1.59742a0000000p-5f,
    0x1.030dc60000000p-5f, 0x1.84869e0000000p-6f, 0x1.235a720000000p-6f, 0x1.b4f7e40000000p-7f,
    0x1.47ae140000000p-7f, 0x1.eb73600000000p-8f, 0x1.7089380000000p-8f, 0x1.145cee0000000p-8f,
    0x1.9e7c700000000p-9f, 0x1.36d21a0000000p-9f, 0x1.d22a500000000p-10f, 0x1.5d931c0000000p-10f,
    0x1.0624de0000000p-10f, 0x1.8929180000000p-11f, 0x1.26d42c0000000p-11f, 0x1.ba2e4e0000000p-12f,
    0x1.4b96c00000000p-12f, 0x1.f1502a0000000p-13f, 0x1.74eea60000000p-13f, 0x1.17a8e40000000p-13f};

DI unsigned pack2(float a, float b) {
  f2_t v = {a, b};
  bf2_t r = __builtin_convertvector(v, bf2_t);
  return __builtin_bit_cast(unsigned, r);
}
DI bf16_t f2bf(float a) {
  __bf16 r = (__bf16)a;
  return __builtin_bit_cast(bf16_t, r);
}
DI float bf2f(bf16_t u) { return __uint_as_float(((unsigned)u) << 16); }
DI float bfs(short u) { return __uint_as_float(((unsigned)(unsigned short)u) << 16); }
DI bf16x8 pack8(const float* t) {
  u32x4 u = {pack2(t[0], t[1]), pack2(t[2], t[3]), pack2(t[4], t[5]), pack2(t[6], t[7])};
  return __builtin_bit_cast(bf16x8, u);
}
DI u32x2 pack4(float a, float b, float c, float d) {
  u32x2 u = {pack2(a, b), pack2(c, d)};
  return u;
}
DI int crow(int i, int h) { return (i & 3) + 8 * (i >> 2) + 4 * h; }
DI float wave_sum(float v) {
#pragma unroll
  for (int o = 32; o > 0; o >>= 1) v += __shfl_xor(v, o);
  return v;
}
DI float ex2(float a) { return __builtin_amdgcn_exp2f(a); }
DI float frcp(float a) { return __builtin_amdgcn_rcpf(a); }
DI float frsq(float a) { return __builtin_amdgcn_rsqf(a); }
DI float silu_f(float a) { return a * frcp(1.f + ex2(-1.4426950408889634f * a)); }
DI float sigmoid_f(float a) { return frcp(1.f + ex2(-1.4426950408889634f * a)); }
DI void zero16(f32x16& a) {
#pragma unroll
  for (int i = 0; i < 16; ++i) a[i] = 0.f;
}

DI void sincos_red(float ang, float& s, float& c) {
  double a = (double)ang;
  double q = rint(a * 0.63661977236758134308);
  double rr = fma(-q, 1.57079632679489655800, a);
  rr = fma(-q, 6.12323399573676603587e-17, rr);
  double r2 = rr * rr;
  double sp = rr * (1.0 + r2 * (-1.0 / 6.0 + r2 * (1.0 / 120.0 + r2 * (-1.0 / 5040.0 + r2 * (1.0 / 362880.0 +
              r2 * (-1.0 / 39916800.0 + r2 * (1.0 / 6227020800.0)))))));
  double cp = 1.0 + r2 * (-0.5 + r2 * (1.0 / 24.0 + r2 * (-1.0 / 720.0 + r2 * (1.0 / 40320.0 +
              r2 * (-1.0 / 3628800.0 + r2 * (1.0 / 479001600.0 + r2 * (-1.0 / 87178291200.0)))))));
  int qi = ((int)q) & 3;
  double ss = (qi & 1) ? cp : sp, cc = (qi & 1) ? sp : cp;
  if (qi == 1) cc = -cc;
  else if (qi == 2) { ss = -ss; cc = -cc; }
  else if (qi == 3) ss = -ss;
  s = (float)ss;
  c = (float)cc;
}

DI int inmap(int n) { return n < 5376 ? n : (n < 8448 ? n + 16 : (n < 8464 ? n - 8448 + 5376 : -1)); }

template <class AL, class BL>
DI void gemm_loop(f32x16 (&acc)[2][2], AL aload, BL bload, int nslab, char* lds, const int tid) {
  const int lane = tid & 63, wave = tid >> 6;
  const int wm = wave >> 1, wn = wave & 1, r = lane & 31, hh = lane >> 5;
  const int lrow = tid >> 3, kc = tid & 7;
  bf16_t* la = (bf16_t*)lds;
  bf16_t* lb = (bf16_t*)(lds + 36864);
  bf16x8 ra0[4], rb0[4], ra1[4], rb1[4];
  auto gl = [&](bf16x8 (&ra)[4], bf16x8 (&rb)[4], int s) {
#pragma unroll
    for (int i = 0; i < 4; ++i) {
      ra[i] = aload(lrow + 32 * i, s * 64 + kc * 8, i);
      rb[i] = bload(lrow + 32 * i, s * 64 + kc * 8);
    }
  };
  auto st = [&](const bf16x8 (&ra)[4], const bf16x8 (&rb)[4], int s) {
    bf16_t* A2 = la + (s & 1) * (128 * 72);
    bf16_t* B2 = lb + (s & 1) * (128 * 72);
#pragma unroll
    for (int i = 0; i < 4; ++i) {
      *(bf16x8*)(A2 + (lrow + 32 * i) * 72 + kc * 8) = ra[i];
      *(bf16x8*)(B2 + (lrow + 32 * i) * 72 + kc * 8) = rb[i];
    }
  };
  auto compute = [&](int s) {
    const bf16_t* A = la + (s & 1) * (128 * 72);
    const bf16_t* B = lb + (s & 1) * (128 * 72);
#pragma unroll
    for (int ks = 0; ks < 4; ++ks) {
      bf16x8 af[2], bfr[2];
#pragma unroll
      for (int mt = 0; mt < 2; ++mt) af[mt] = *(const bf16x8*)(A + (wm * 64 + mt * 32 + r) * 72 + ks * 16 + hh * 8);
#pragma unroll
      for (int nt = 0; nt < 2; ++nt) bfr[nt] = *(const bf16x8*)(B + (wn * 64 + nt * 32 + r) * 72 + ks * 16 + hh * 8);
#pragma unroll
      for (int mt = 0; mt < 2; ++mt)
#pragma unroll
        for (int nt = 0; nt < 2; ++nt) acc[mt][nt] = MFMA32(af[mt], bfr[nt], acc[mt][nt]);
    }
  };
  gl(ra0, rb0, 0);
  if (nslab > 1) gl(ra1, rb1, 1);
  __syncthreads();
  st(ra0, rb0, 0);
  for (int s = 0; s < nslab; s += 2) {
    __syncthreads();
    st(ra1, rb1, s + 1);
    if (s + 2 < nslab) gl(ra0, rb0, s + 2);
    compute(s);
    __syncthreads();
    if (s + 2 < nslab) st(ra0, rb0, s + 2);
    if (s + 3 < nslab) gl(ra1, rb1, s + 3);
    compute(s + 1);
  }
}

template <class CM>
DI void transpose_tile(const float* src, int ld_src, int k0, int n0, CM colmap, const float* kscale, bf16_t* dst,
                       int ld_dst, float* tl, const int tid) {
  __syncthreads();
  {
    const int nn = tid & 63, kq = tid >> 6;
    const int oc = colmap(n0 + nn);
    const float* sp = src + (size_t)(k0 + kq) * ld_src + (oc >= 0 ? oc : 0);
    float v[16];
#pragma unroll
    for (int j = 0; j < 16; ++j) v[j] = sp[(size_t)(4 * j) * ld_src];
#pragma unroll
    for (int j = 0; j < 16; ++j) {
      float x = oc >= 0 ? v[j] : 0.f;
      if (kscale) x *= kscale[k0 + kq + 4 * j];
      tl[(kq + 4 * j) * 65 + nn] = x;
    }
  }
  __syncthreads();
  for (int i = tid; i < 512; i += 256) {
    int nn = i >> 3, kg = i & 7;
    float t[8];
#pragma unroll
    for (int j = 0; j < 8; ++j) t[j] = tl[(kg * 8 + j) * 65 + nn];
    *(bf16x8*)(dst + (size_t)(n0 + nn) * ld_dst + k0 + kg * 8) = pack8(t);
  }
}

DI void do_wtile(const Params& p, int t, float* tl, const int tid) {
  auto ident = [](int n) { return n; };
  if (t < 8576) {
    int l = t / 2144, rem = t % 2144;
    int kt = rem / 134, nt = rem % 134;
    transpose_tile(p.w_in + (size_t)l * 1024 * 8464, 8464, kt * 64, nt * 64, inmap, p.norm_g + l * 1024,
                   p.wt_in() + (size_t)l * DINP * 1024, 1024, tl, tid);
  } else if (t < 10112) {
    int u = t - 8576;
    int mat = u >> 7, rem = u & 127;
    int l = mat / 3, br = mat % 3;
    int kt = rem >> 4, nt = rem & 15;
    const float* src = (br == 0 ? p.w_bo_a : (br == 1 ? p.w_bo_b : p.w_bo_c)) + (size_t)l * 512 * 1024;
    transpose_tile(src, 1024, kt * 64, nt * 64, ident, (const float*)nullptr, p.wt_bo() + (size_t)mat * 1024 * 512, 512, tl, tid);
  } else {
    int u = t - 10112;
    int l = u >> 8, rem = u & 255;
    int kt = rem >> 4, nt = rem & 15;
    transpose_tile(p.w_out + (size_t)l * 1024 * 1024, 1024, kt * 64, nt * 64, ident, (const float*)nullptr,
                   p.wt_out() + (size_t)l * 1024 * 1024, 1024, tl, tid);
  }
}

DI void phase0(const Params& p, char* lds) {
  int tid_ = threadIdx.x;
  asm volatile("" : "+v"(tid_));
  int nb_ = gridDim.x;
  asm volatile("" : "+s"(nb_));
  const int tid = tid_, bid = blockIdx.x, nb = nb_;
  const int gtid = bid * 256 + tid, gsz = nb * 256;
  for (int i = gtid; i < 4 * NTOK; i += gsz) p.rowss()[NTOK + i] = 0.f;
  if (bid == 0 && tid < 64) p.ctr()[tid] = 0u;
  if (bid == 0 && tid < 4) {
    const int l = tid;
    const float* bl = p.b_lambda + l * 256;
    float s1 = 0.f, s2 = 0.f;
    for (int j = 0; j < 64; ++j) {
      s1 += bl[j] * bl[64 + j];
      s2 += bl[128 + j] * bl[192 + j];
    }
    float lam_init = 0.8f - 0.6f * expf(-0.3f * (float)l);
    p.lam()[l] = expf(s1) - expf(s2) + lam_init;
    p.lam()[4 + l] = lam_init;
  }
  for (int i = gtid; i < S * 32; i += gsz) {
    int pos = i >> 5, j = i & 31;
    float ang = (float)pos * kInvFreq[j];
    float s, c;
    sincos_red(ang, s, c);
    p.ropec()[i] = c;
    p.ropes()[i] = s;
  }
  {
    const int lane = tid & 63;
    const int gw = bid * 4 + (tid >> 6);
    for (int row = gw; row < NTOK; row += nb * 4) {
      const float4* src = (const float4*)(p.x + (size_t)row * 1024);
      float ss = 0.f;
#pragma unroll
      for (int i = 0; i < 4; ++i) {
        float4 v = src[lane + 64 * i];
        ss += v.x * v.x + v.y * v.y + v.z * v.z + v.w * v.w;
        *(u32x2*)(p.xb() + (size_t)row * 1024 + (lane + 64 * i) * 4) = pack4(v.x, v.y, v.z, v.w);
      }
      ss = wave_sum(ss);
      if (lane == 0) p.rowss()[row] = ss;
    }
  }
  float* tl = (float*)lds;
  for (int t = bid; t < 2144; t += nb) do_wtile(p, t, tl, tid);
}

DI void p1_tile(const Params& p, int l, int m, int n, char* lds) {
  int tid_ = threadIdx.x;
  asm volatile("" : "+v"(tid_));
  const int tid = tid_, lane = tid & 63, wave = tid >> 6;
  const int wm = wave >> 1, wn = wave & 1, r = lane & 31, hh = lane >> 5;
  f32x16 acc[2][2];
#pragma unroll
  for (int a = 0; a < 2; ++a)
#pragma unroll
    for (int b = 0; b < 2; ++b) zero16(acc[a][b]);
  const bf16_t* A = p.xb() + (size_t)(m * 128) * 1024;
  const bf16_t* B = p.wt_in() + ((size_t)l * DINP + n * 128) * 1024;
  float* rsl = (float*)(lds + LDS_MAIN);
  if (tid < 128) rsl[tid] = frsq(p.rowss()[(size_t)l * NTOK + m * 128 + tid] * (1.f / 1024.f) + 1e-6f);
  gemm_loop(
      acc, [&](int row, int k, int) { return *(const bf16x8*)(A + (size_t)row * 1024 + k); },
      [&](int row, int k) { return *(const bf16x8*)(B + (size_t)row * 1024 + k); }, 16, lds, tid);

  const int colb = n * 128;
  const float* rss = p.rowss() + (size_t)l * NTOK;
  if (colb >= 8448) {
    if (wn == 0 && r < 16) {
#pragma unroll
      for (int mt = 0; mt < 2; ++mt)
#pragma unroll
        for (int i = 0; i < 16; ++i) {
          const int row = m * 128 + wm * 64 + mt * 32 + crow(i, hh);
          const float v = acc[mt][0][i] * rsqrtf(rss[row] * (1.f / 1024.f) + 1e-6f);
          float o;
          if (r < 8) o = sigmoid_f(v);
          else {
            const int jj = r - 8;
            const float xx = v + p.c_dt_bias[l * 8 + jj];
            const float sp = fmaxf(xx, 0.f) + __logf(1.f + __expf(-fabsf(xx)));
            o = -__expf(p.c_a_log[l * 8 + jj]) * sp;
          }
          p.betag()[(size_t)row * 16 + r] = o;
        }
    }
    return;
  }
  int mode;
  bf16_t* dst;
  int ld, cl0;
  float scale = 1.f;
  const int bb = (m * 128) >> 13, s0 = (m * 128) & (S - 1);
  if (colb < 512) { mode = 3; dst = p.qa(); ld = 512; cl0 = colb; scale = QSCALE; }
  else if (colb < 640) { mode = 3; dst = p.ka(); ld = 128; cl0 = colb - 512; }
  else if (colb < 768) { mode = 4; dst = p.vat() + ((size_t)bb * 128) * S + s0; ld = S; cl0 = 0; }
  else if (colb < 1280) { mode = 1; dst = p.za(); ld = 512; cl0 = colb - 768; }
  else if (colb < 1792) { mode = 3; dst = p.qb(); ld = 512; cl0 = colb - 1280; scale = QSCALE; }
  else if (colb < 2304) { mode = 3; dst = p.kb(); ld = 512; cl0 = colb - 1792; }
  else if (colb < 2816) { mode = 4; dst = p.vbt() + ((size_t)(bb * 4 + ((colb - 2304) >> 7)) * 128) * S + s0; ld = S; cl0 = 0; }
  else if (colb < 3328) { mode = 1; dst = p.zb(); ld = 512; cl0 = colb - 2816; }
  else if (colb < 4864) { mode = 0; dst = p.cqkv(); ld = 1536; cl0 = colb - 3328; }
  else if (colb < 5376) { mode = 1; dst = p.zc(); ld = 512; cl0 = colb - 4864; }
  else { mode = 2; dst = p.gate(); ld = 3072; cl0 = colb - 5376; }
  bf16_t* ct = (bf16_t*)lds;
  __syncthreads();
#pragma unroll
  for (int mt = 0; mt < 2; ++mt)
#pragma unroll
    for (int i = 0; i < 16; ++i) {
      const float rs = rsl[wm * 64 + mt * 32 + crow(i, hh)];
      acc[mt][0][i] *= rs;
      acc[mt][1][i] *= rs;
    }
  const int cl = wn * 64 + r;
  bf16_t* cw = ct + (wm * 64 + 4 * hh) * 136 + cl;
  if (mode == 4) {
#pragma unroll
    for (int mt = 0; mt < 2; ++mt)
#pragma unroll
      for (int ig = 0; ig < 4; ++ig) {
        const int rl0 = wm * 64 + mt * 32 + 8 * ig + 4 * hh;
        *(u32x2*)(ct + cl * 136 + rl0) = pack4(acc[mt][0][ig * 4], acc[mt][0][ig * 4 + 1], acc[mt][0][ig * 4 + 2], acc[mt][0][ig * 4 + 3]);
        *(u32x2*)(ct + (cl + 32) * 136 + rl0) = pack4(acc[mt][1][ig * 4], acc[mt][1][ig * 4 + 1], acc[mt][1][ig * 4 + 2], acc[mt][1][ig * 4 + 3]);
      }
  } else if (mode == 3) {
#pragma unroll
    for (int mt = 0; mt < 2; ++mt)
#pragma unroll
      for (int i = 0; i < 16; ++i) {
        const int rloc = mt * 32 + (i & 3) + 8 * (i >> 2);
        const int pos = s0 + wm * 64 + 4 * hh + rloc;
        const float c = p.ropec()[pos * 32 + r], s = p.ropes()[pos * 32 + r];
        const float v0 = acc[mt][0][i], v1 = acc[mt][1][i];
        cw[rloc * 136] = f2bf((v0 * c - v1 * s) * scale);
        cw[rloc * 136 + 32] = f2bf((v1 * c + v0 * s) * scale);
      }
  } else if (mode == 2) {
#pragma unroll
    for (int mt = 0; mt < 2; ++mt)
#pragma unroll
      for (int i = 0; i < 16; ++i) {
        const int rloc = mt * 32 + (i & 3) + 8 * (i >> 2);
        cw[rloc * 136] = f2bf(sigmoid_f(acc[mt][0][i]));
        cw[rloc * 136 + 32] = f2bf(sigmoid_f(acc[mt][1][i]));
      }
  } else if (mode == 1) {
#pragma unroll
    for (int mt = 0; mt < 2; ++mt)
#pragma unroll
      for (int i = 0; i < 16; ++i) {
        const int rloc = mt * 32 + (i & 3) + 8 * (i >> 2);
        cw[rloc * 136] = f2bf(silu_f(acc[mt][0][i]));
        cw[rloc * 136 + 32] = f2bf(silu_f(acc[mt][1][i]));
      }
  } else {
#pragma unroll
    for (int mt = 0; mt < 2; ++mt)
#pragma unroll
      for (int i = 0; i < 16; ++i) {
        const int rloc = mt * 32 + (i & 3) + 8 * (i >> 2);
        cw[rloc * 136] = f2bf(acc[mt][0][i]);
        cw[rloc * 136 + 32] = f2bf(acc[mt][1][i]);
      }
  }
  __syncthreads();
#pragma unroll
  for (int j = 0; j < 8; ++j) {
    const int c = tid + 256 * j;
    const int rr = c >> 4, cc = c & 15;
    const bf16x8 v = *(const bf16x8*)(ct + rr * 136 + cc * 8);
    if (mode == 4) *(bf16x8*)(dst + (size_t)rr * S + cc * 8) = v;
    else *(bf16x8*)(dst + (size_t)(m * 128 + rr) * ld + cl0 + cc * 8) = v;
  }
}

template <int DV, bool WIN>
DI void attn_core(f32x16 (&o)[DV / 32], float& m_run, float& l_run, const bf16x8 (&qf)[4], const bf16_t* kptr, int ldk,
                  const bf16_t* vtptr, int kt0, int kt1, int qpos, char* lds, const int tid) {
  constexpr int NV = DV / 32;
  constexpr int KS_BYTES = 64 * 72 * 2;
  constexpr int BUF = KS_BYTES + 128 * 72 * 2;
  const int lane = tid & 63;
  const int r = lane & 31, hh = lane >> 5;
  const int lrow = tid >> 3, kc = tid & 7;
  bf16x8 kreg[2], vreg[NV];
  auto gload = [&](int kt) {
#pragma unroll
    for (int i = 0; i < 2; ++i) kreg[i] = *(const bf16x8*)(kptr + (size_t)(kt * 64 + lrow + 32 * i) * ldk + kc * 8);
#pragma unroll
    for (int i = 0; i < NV; ++i) vreg[i] = *(const bf16x8*)(vtptr + (size_t)(lrow + 32 * i) * S + kt * 64 + kc * 8);
  };
  auto lstore = [&](int buf) {
    char* base = lds + buf * BUF;
#pragma unroll
    for (int i = 0; i < 2; ++i) *(bf16x8*)(base + ((lrow + 32 * i) * 72 + kc * 8) * 2) = kreg[i];
#pragma unroll
    for (int i = 0; i < NV; ++i) {
      u32x4 v = __builtin_bit_cast(u32x4, vreg[i]);
      char* d = base + KS_BYTES + (lrow + 32 * i) * 144 + (kc >> 1) * 32 + (kc & 1) * 8;
      u32x2 lo = {v.x, v.y}, hi = {v.z, v.w};
      *(u32x2*)d = lo;
      *(u32x2*)(d + 16) = hi;
    }
  };
  __syncthreads();
  gload(kt0);
  lstore(0);
  f32x16 minit;
#pragma unroll
  for (int i = 0; i < 16; ++i) minit[i] = -m_run;
  bool first = !WIN;
  for (int kt = kt0; kt < kt1; ++kt) {
    const int buf = (kt - kt0) & 1;
    const bool more = (kt + 1 < kt1);
    if (more) gload(kt + 1);
    __syncthreads();
    const char* base = lds + buf * BUF;
    const bf16_t* Ks = (const bf16_t*)base;
    const bf16_t* Vs = (const bf16_t*)(base + KS_BYTES);
    bf16x8 kf[4][2];
#pragma unroll
    for (int ks = 0; ks < 4; ++ks)
#pragma unroll
      for (int t = 0; t < 2; ++t) kf[ks][t] = *(const bf16x8*)(Ks + (t * 32 + r) * 72 + ks * 16 + hh * 8);
#pragma unroll
    for (int ks = 0; ks < 4; ++ks)
#pragma unroll
      for (int t = 0; t < 2; ++t) asm volatile("" : "+v"(kf[ks][t]));
    f32x16 s[2];
#pragma unroll
    for (int t = 0; t < 2; ++t) {
      s[t] = MFMA32(kf[0][t], qf[0], minit);
#pragma unroll
      for (int ks = 1; ks < 4; ++ks) s[t] = MFMA32(kf[ks][t], qf[ks], s[t]);
    }
    auto vread = [&](int g, int mt) {
      return *(const bf16x8*)(Vs + (mt * 32 + r) * 72 + g * 16 + 8 * hh);
    };
    bf16x8 vcur[NV], vnxt[NV];
#pragma unroll
    for (int mt = 0; mt < NV; ++mt) vcur[mt] = vread(0, mt);
    if (WIN) {
#pragma unroll
      for (int t = 0; t < 2; ++t)
#pragma unroll
        for (int i = 0; i < 16; ++i) {
          int d = kt * 64 + t * 32 + crow(i, hh) - qpos;
          if (d > 128 || d < -128) s[t][i] = -1e30f;
        }
    }
    float mx = s[0][0];
#pragma unroll
    for (int t = 0; t < 2; ++t)
#pragma unroll
      for (int i = 0; i < 16; ++i) mx = fmaxf(mx, s[t][i]);
    {
      auto rr = __builtin_amdgcn_permlane32_swap(__float_as_uint(mx), __float_as_uint(mx), false, false);
      mx = fmaxf(__uint_as_float(rr[0]), __uint_as_float(rr[1]));
    }
    if (first || __any(mx > 8.f)) {
      const float delta = (first || mx > 8.f) ? mx : 0.f;
      first = false;
      m_run += delta;
      const float alpha = ex2(-delta);
      l_run *= alpha;
#pragma unroll
      for (int i = 0; i < 16; ++i) minit[i] = -m_run;
#pragma unroll
      for (int t = 0; t < 2; ++t)
#pragma unroll
        for (int i = 0; i < 16; ++i) s[t][i] -= delta;
#pragma unroll
      for (int mt = 0; mt < NV; ++mt)
#pragma unroll
        for (int i = 0; i < 16; ++i) o[mt][i] *= alpha;
    }
    float psum = 0.f;
#pragma unroll
    for (int t = 0; t < 2; ++t)
#pragma unroll
      for (int i = 0; i < 16; ++i) {
        float pv = ex2(s[t][i]);
        s[t][i] = pv;
        psum += pv;
      }
    l_run += psum;
#pragma unroll
    for (int g = 0; g < 4; ++g) {
      if (g < 3) {
#pragma unroll
        for (int mt = 0; mt < NV; ++mt) vnxt[mt] = vread(g + 1, mt);
      }
      float tmp[8];
#pragma unroll
      for (int j = 0; j < 8; ++j) tmp[j] = s[g >> 1][8 * (g & 1) + j];
      bf16x8 pf = pack8(tmp);
#pragma unroll
      for (int mt = 0; mt < NV; ++mt) o[mt] = MFMA32(vcur[mt], pf, o[mt]);
#pragma unroll
      for (int mt = 0; mt < NV; ++mt) vcur[mt] = vnxt[mt];
    }
    if (more) lstore(buf ^ 1);
  }
}

DI void battn_item(const Params& p, int l, int b, int h, int qblk, int c, char* lds) {
  int tid_ = threadIdx.x;
  asm volatile("" : "+v"(tid_));
  const int tid = tid_, lane = tid & 63, wave = tid >> 6;
  const int r = lane & 31, hh = lane >> 5;
  const int q = qblk * 128 + wave * 32 + r;
  const size_t tok = (size_t)b * S + q;
  f32x16 o[4];
  bf16x8 qf[4];
#pragma unroll
  for (int ks = 0; ks < 4; ++ks) qf[ks] = *(const bf16x8*)(p.qb() + tok * 512 + h * 128 + c * 64 + ks * 16 + hh * 8);
#pragma unroll
  for (int mt = 0; mt < 4; ++mt) zero16(o[mt]);
  float m = 0.f, lsum = 0.f;
  attn_core<128, false>(o, m, lsum, qf, p.kb() + (size_t)b * S * 512 + h * 128 + c * 64, 512,
                        p.vbt() + (size_t)(b * 4 + h) * 128 * S, 0, 128, 0, lds, tid);
  lsum += __shfl_xor(lsum, 32);
  const float inv = 1.f / lsum;
  bf16_t* op = (c ? p.ob1() : p.ob0()) + tok * 512 + h * 128 + 4 * hh;
#pragma unroll
  for (int mt = 0; mt < 4; ++mt)
#pragma unroll
    for (int ig = 0; ig < 4; ++ig)
      *(u32x2*)(op + mt * 32 + 8 * ig) = pack4(o[mt][ig * 4 + 0] * inv, o[mt][ig * 4 + 1] * inv, o[mt][ig * 4 + 2] * inv,
                                               o[mt][ig * 4 + 3] * inv);
}

DI void aattn_item(const Params& p, int l, int b, int qblk, int h, char* lds) {
  int tid_ = threadIdx.x;
  asm volatile("" : "+v"(tid_));
  const int tid = tid_, lane = tid & 63, wave = tid >> 6;
  const int r = lane & 31, hh = lane >> 5;
  const int q = qblk * 128 + wave * 32 + r;
  const size_t tok = (size_t)b * S + q;
  const int kvh = h >> 2;
  bf16x8 qf[4];
#pragma unroll
  for (int ks = 0; ks < 4; ++ks) qf[ks] = *(const bf16x8*)(p.qa() + tok * 512 + h * 64 + ks * 16 + hh * 8);
  f32x16 o[2];
  zero16(o[0]);
  zero16(o[1]);
  float m = p.a_sink[l * 8 + h] * LOG2E;
  float lsum = hh == 0 ? 1.f : 0.f;
  const int kt0 = max(0, 2 * (qblk - 1)), kt1 = min(128, 2 * (qblk + 2));
  attn_core<64, true>(o, m, lsum, qf, p.ka() + (size_t)b * S * 128 + kvh * 64, 128, p.vat() + (size_t)(b * 2 + kvh) * 64 * S,
                      kt0, kt1, q, lds, tid);
  lsum += __shfl_xor(lsum, 32);
  const float inv = 1.f / lsum;
#pragma unroll
  for (int mt = 0; mt < 2; ++mt)
#pragma unroll
    for (int ig = 0; ig < 4; ++ig) {
      const int e0 = mt * 32 + 8 * ig + 4 * hh;
      u32x2 zz = *(const u32x2*)(p.za() + tok * 512 + h * 64 + e0);
      float y0 = o[mt][ig * 4 + 0] * inv * __uint_as_float(zz.x << 16);
      float y1 = o[mt][ig * 4 + 1] * inv * __uint_as_float(zz.x & 0xffff0000u);
      float y2 = o[mt][ig * 4 + 2] * inv * __uint_as_float(zz.y << 16);
      float y3 = o[mt][ig * 4 + 3] * inv * __uint_as_float(zz.y & 0xffff0000u);
      *(u32x2*)(p.oa() + tok * 512 + h * 64 + e0) = pack4(y0, y1, y2, y3);
    }
}

DI void c1_item(const Params& p, int l, int b, int h, int n, char* lds) {
  int tid_ = threadIdx.x;
  asm volatile("" : "+v"(tid_));
  const int tid = tid_, lane = tid & 63, wave = tid >> 6;
  const int r = lane & 31, hh = lane >> 5;
  bf16_t* q_rm = (bf16_t*)lds;
  bf16_t* k_rm = (bf16_t*)(lds + 17408);
  bf16_t* k_tr = (bf16_t*)(lds + 34816);
  bf16_t* v_tr = (bf16_t*)(lds + 53248);
  float* sm = (float*)(lds + 71680);
  float* Am = (float*)lds;
  const size_t tok0 = (size_t)b * S + n * 64;
  __syncthreads();
#pragma unroll 1
  for (int itb = 0; itb < 6; itb += 3) {
    float w[3][5], xin[3][20];
#pragma unroll
    for (int u = 0; u < 3; ++u) {
      const int idx = tid + 256 * (itb + u);
      const int ch = idx & 127, run = (idx >> 7) & 3, mm = idx >> 9;
      const int gcol = mm * 512 + h * 128 + ch;
#pragma unroll
      for (int tap = 0; tap < 5; ++tap) w[u][tap] = p.c_conv_w[(size_t)(l * 5 + tap) * 1536 + gcol];
#pragma unroll
      for (int jj = 0; jj < 20; ++jj) {
        int t = n * 64 + run * 16 - 2 + jj;
        xin[u][jj] = (t >= 0 && t < S) ? bf2f(p.cqkv()[((size_t)b * S + t) * 1536 + gcol]) : 0.f;
      }
    }
#pragma unroll
    for (int u = 0; u < 3; ++u) {
      const int idx = tid + 256 * (itb + u);
      const int ch = idx & 127, run = (idx >> 7) & 3, mm = idx >> 9;
      float y[16];
#pragma unroll
      for (int j = 0; j < 16; ++j) {
        float a = 0.f;
#pragma unroll
        for (int tap = 0; tap < 5; ++tap) a += w[u][tap] * xin[u][j + tap];
        y[j] = silu_f(a);
      }
      if (mm == 0) {
#pragma unroll
        for (int j = 0; j < 16; ++j) q_rm[(run * 16 + j) * 136 + ch] = f2bf(y[j]);
      } else {
        if (mm == 1) {
#pragma unroll
          for (int j = 0; j < 16; ++j) k_rm[(run * 16 + j) * 136 + ch] = f2bf(y[j]);
        }
        bf16_t* dst = (mm == 1 ? k_tr : v_tr) + ch * 72 + run * 16;
        *(bf16x8*)dst = pack8(y);
        *(bf16x8*)(dst + 8) = pack8(y + 8);
      }
    }
  }
  if (tid < 128) {
    const int dir = tid >> 6;
    const int c = dir ? 63 - lane : lane;
    const float* bg = p.betag() + (tok0 + c) * 16;
    float v = bg[8 + dir * 4 + h];
    const float be = bg[dir * 4 + h];
#pragma unroll
    for (int off = 1; off < 64; off <<= 1) {
      float t = __shfl_up(v, off);
      if (lane >= off) v += t;
    }
    sm[dir * 64 + c] = v;
    sm[128 + dir * 64 + c] = be;
  }
  __syncthreads();
  const int ti = wave >> 1, tj = wave & 1;
  f32x16 kk, qk, qq;
  zero16(kk);
  zero16(qk);
  zero16(qq);
#pragma unroll
  for (int ks = 0; ks < 8; ++ks) {
    bf16x8 ka_ = *(const bf16x8*)(k_rm + (ti * 32 + r) * 136 + ks * 16 + hh * 8);
    bf16x8 kb_ = *(const bf16x8*)(k_rm + (tj * 32 + r) * 136 + ks * 16 + hh * 8);
    bf16x8 qa_ = *(const bf16x8*)(q_rm + (ti * 32 + r) * 136 + ks * 16 + hh * 8);
    kk = MFMA32(ka_, kb_, kk);
    qk = MFMA32(qa_, kb_, qk);
    if (wave < 2) {
      bf16x8 qd_ = *(const bf16x8*)(q_rm + (wave * 32 + r) * 136 + ks * 16 + hh * 8);
      qq = MFMA32(qd_, qd_, qq);
    }
  }
  {
    float dk = 0.f, dq = 0.f;
#pragma unroll
    for (int i = 0; i < 16; ++i) {
      bool sel = (crow(i, hh) == r);
      dk = sel ? kk[i] : dk;
      dq = sel ? qq[i] : dq;
    }
    const bool own = (hh == ((r >> 2) & 1));
    if (own && ti == tj) sm[320 + ti * 32 + r] = rsqrtf(dk + 1e-6f);
    if (own && wave < 2) sm[256 + wave * 32 + r] = rsqrtf(dq + 1e-6f) * 0.08838834764831845f;
  }
  __syncthreads();
  const size_t item0 = (size_t)((b * 4 + h) * 2) * 128 + n, item1 = item0 + 128;
  {
    const int j = tj * 32 + r;
    const float rkj = sm[320 + j], g0j = sm[j], g1j = sm[64 + j];
#pragma unroll
    for (int i = 0; i < 16; ++i) {
      const int irow = ti * 32 + crow(i, hh);
      const float base = qk[i] * sm[256 + irow] * rkj;
      const float a0 = (j <= irow) ? base * __expf(sm[irow] - g0j) : 0.f;
      const float a1 = (j >= irow) ? base * __expf(sm[64 + irow] - g1j) : 0.f;
      p.c_attn()[item0 * 4096 + irow * 64 + j] = f2bf(a0);
      p.c_attn()[item1 * 4096 + irow * 64 + j] = f2bf(a1);
    }
  }
  {
    const float gl0 = sm[63], gl1 = sm[64];
#pragma unroll 1
    for (int dir = 0; dir < 2; ++dir) {
      const size_t item = dir ? item1 : item0;
      const float gl = dir ? gl1 : gl0;
#pragma unroll
      for (int it = 0; it < 4; ++it) {
        const int idx = tid + 256 * it;
        const int c = idx >> 4, dg = idx & 15;
        bf16x8 qv = *(const bf16x8*)(q_rm + c * 136 + dg * 8);
        const float sc = sm[256 + c] * __expf(sm[dir * 64 + c]);
        float t[8];
#pragma unroll
        for (int jj = 0; jj < 8; ++jj) t[jj] = bfs(qv[jj]) * sc;
        *(bf16x8*)(p.c_qd() + item * 8192 + c * 128 + dg * 8) = pack8(t);
      }
#pragma unroll
      for (int it = 0; it < 4; ++it) {
        const int idx = tid + 256 * it;
        const int d = idx >> 3, cg_ = idx & 7;
        bf16x8 kv = *(const bf16x8*)(k_tr + d * 72 + cg_ * 8);
        float t[8];
#pragma unroll
        for (int jj = 0; jj < 8; ++jj) {
          const int c = cg_ * 8 + jj;
          t[jj] = bfs(kv[jj]) * sm[320 + c] * __expf(gl - sm[dir * 64 + c]);
        }
        *(bf16x8*)(p.c_kt() + item * 8192 + d * 64 + cg_ * 8) = pack8(t);
      }
    }
    if (tid == 0) {
      p.c_egl()[item0] = __expf(gl0);
      p.c_egl()[item1] = __expf(gl1);
    }
  }
  __syncthreads();
  {
    const int j = tj * 32 + r;
    const float rkj = sm[320 + j], g0j = sm[j], g1j = sm[64 + j];
#pragma unroll
    for (int i = 0; i < 16; ++i) {
      const int irow = ti * 32 + crow(i, hh);
      const float base = kk[i] * sm[320 + irow] * rkj;
      const float a0 = (j < irow) ? base * sm[128 + irow] * __expf(sm[irow] - g0j) : 0.f;
      const float a1 = (j > irow) ? base * sm[192 + irow] * __expf(sm[64 + irow] - g1j) : 0.f;
      Am[irow * 65 + j] = a0;
      Am[4160 + irow * 65 + j] = a1;
    }
  }
  __syncthreads();
  {
    const int dir = wave >> 1, blk = wave & 1;
    float* T = Am + dir * 4160;
    const int base = 32 * blk;
    const int c = lane & 31;
    float* Tb = T + base * 65 + base + c;
    if (dir == 0) {
      for (int i = 0; i < 32; ++i) {
        const float a = Tb[i * 65];
        float sum = 0.f;
        for (int jb = 0; jb < i; jb += 16) {
#pragma unroll
          for (int jj = 0; jj < 16; ++jj) {
            const int j = jb + jj;
            const float aj = __int_as_float(__builtin_amdgcn_readlane(__float_as_int(a), j));
            sum = fmaf((j < i) ? aj : 0.f, Tb[j * 65], sum);
          }
        }
        Tb[i * 65] = (c == i ? 1.f : 0.f) - sum;
      }
    } else {
      for (int i = 31; i >= 0; --i) {
        const float a = Tb[i * 65];
        float sum = 0.f;
        for (int jb = (i + 1) & ~15; jb < 32; jb += 16) {
#pragma unroll
          for (int jj = 0; jj < 16; ++jj) {
            const int j = jb + jj;
            const float aj = __int_as_float(__builtin_amdgcn_readlane(__float_as_int(a), j));
            sum = fmaf((j > i) ? aj : 0.f, Tb[j * 65], sum);
          }
        }
        Tb[i * 65] = (c == i ? 1.f : 0.f) - sum;
      }
    }
    __syncthreads();
    if (blk == 0) {
      const int ar = dir == 0 ? 32 : 0, ac = dir == 0 ? 0 : 32;
      f32x16 X, Y;
      zero16(X);
      zero16(Y);
#pragma unroll
      for (int s = 0; s < 16; ++s) {
        const float a = T[(ar + r) * 65 + ac + 2 * s + hh];
        const float bq = T[(ac + 2 * s + hh) * 65 + ac + r];
        X = __builtin_amdgcn_mfma_f32_32x32x2f32(a, bq, X, 0, 0, 0);
      }
#pragma unroll
      for (int s = 0; s < 16; ++s) {
        const float a = T[(ar + r) * 65 + ar + crow(s, hh)];
        Y = __builtin_amdgcn_mfma_f32_32x32x2f32(a, X[s], Y, 0, 0, 0);
      }
#pragma unroll
      for (int i = 0; i < 16; ++i) T[(ar + crow(i, hh)) * 65 + ac + r] = -Y[i];
    }
  }
  __syncthreads();
  {
    const int dir = wave >> 1, which = wave & 1;
    const float* T = Am + dir * 4160;
    const bf16_t* Bsrc = which ? k_tr : v_tr;
    bf16_t* dst = (which ? p.c_w() : p.c_u()) + (dir ? item1 : item0) * 8192;
#pragma unroll 1
    for (int half = 0; half < 2; ++half) {
      f32x16 acc[2][2];
#pragma unroll
      for (int a = 0; a < 2; ++a)
#pragma unroll
        for (int bb = 0; bb < 2; ++bb) zero16(acc[a][bb]);
#pragma unroll
      for (int ks = 0; ks < 4; ++ks) {
        float cs[8];
#pragma unroll
        for (int jj = 0; jj < 8; ++jj) {
          const int j = ks * 16 + hh * 8 + jj;
          float c = sm[128 + dir * 64 + j];
          if (which) c *= sm[320 + j] * __expf(sm[dir * 64 + j]);
          cs[jj] = c;
        }
        bf16x8 af[2];
#pragma unroll
        for (int mt = 0; mt < 2; ++mt) {
          const float* tp = T + (mt * 32 + r) * 65 + ks * 16 + hh * 8;
          float t8[8];
#pragma unroll
          for (int jj = 0; jj < 8; ++jj) t8[jj] = tp[jj] * cs[jj];
          af[mt] = pack8(t8);
        }
#pragma unroll
        for (int nt = 0; nt < 2; ++nt) {
          bf16x8 bfr = *(const bf16x8*)(Bsrc + ((half * 2 + nt) * 32 + r) * 72 + ks * 16 + hh * 8);
#pragma unroll
          for (int mt = 0; mt < 2; ++mt) acc[mt][nt] = MFMA32(af[mt], bfr, acc[mt][nt]);
        }
      }
#pragma unroll
      for (int mt = 0; mt < 2; ++mt)
#pragma unroll
        for (int nt = 0; nt < 2; ++nt)
#pragma unroll
          for (int i = 0; i < 16; ++i) {
            const int c = mt * 32 + crow(i, hh), e = (half * 2 + nt) * 32 + r;
            dst[c * 128 + e] = f2bf(acc[mt][nt][i]);
          }
    }
  }
}

struct ScanRegs {
  bf16x8 wf[4], qf[4], af[2], kf[2][2];
  bf16_t u[2][4];
  float egl;
};

DI void c2_load(const Params& p, ScanRegs& R, size_t item, int sl, int wave, int l15, int q4) {
  const bf16_t* W = p.c_w() + item * 8192;
  const bf16_t* QD = p.c_qd() + item * 8192;
  const bf16_t* U = p.c_u() + item * 8192 + (16 * wave + q4 * 4) * 128 + sl * 32 + l15;
  const bf16_t* AT = p.c_attn() + item * 4096;
  const bf16_t* KT = p.c_kt() + item * 8192;
  R.egl = __hip_atomic_load(&p.c_egl()[item], __ATOMIC_RELAXED, __HIP_MEMORY_SCOPE_AGENT);
#pragma unroll
  for (int ks = 0; ks < 4; ++ks) {
    R.wf[ks] = *(const bf16x8*)(W + (16 * wave + l15) * 128 + ks * 32 + q4 * 8);
    R.qf[ks] = *(const bf16x8*)(QD + (16 * wave + l15) * 128 + ks * 32 + q4 * 8);
  }
#pragma unroll
  for (int ks = 0; ks < 2; ++ks) R.af[ks] = *(const bf16x8*)(AT + (16 * wave + l15) * 64 + ks * 32 + q4 * 8);
#pragma unroll
  for (int mt = 0; mt < 2; ++mt)
#pragma unroll
    for (int ks = 0; ks < 2; ++ks) R.kf[mt][ks] = *(const bf16x8*)(KT + (32 * wave + mt * 16 + l15) * 64 + ks * 32 + q4 * 8);
#pragma unroll
  for (int nt = 0; nt < 2; ++nt)
#pragma unroll
    for (int i = 0; i < 4; ++i) R.u[nt][i] = U[i * 128 + nt * 16];
}

DI void c2_item(const Params& p, int b, int h, int dir, int sl, char* lds) {
  int tid_ = threadIdx.x;
  asm volatile("" : "+v"(tid_));
  const int tid = tid_, lane = tid & 63, wave = tid >> 6;
  const int l15 = lane & 15, q4 = lane >> 4;
  __builtin_amdgcn_s_setprio(3);
  bf16_t* St = (bf16_t*)lds;
  bf16_t* VnT = (bf16_t*)(lds + 8704);
  __syncthreads();
  for (int i = tid; i < 32 * 136 / 2; i += 256) ((unsigned*)St)[i] = 0u;
  f32x4 sacc[2][2];
#pragma unroll
  for (int a = 0; a < 2; ++a)
#pragma unroll
    for (int bb = 0; bb < 2; ++bb) sacc[a][bb] = (f32x4){0.f, 0.f, 0.f, 0.f};
  __syncthreads();
  const size_t itembase = (size_t)((b * 4 + h) * 2 + dir) * 128;
  ScanRegs RA, RB;
  auto do_step = [&](const ScanRegs& cur, int step) {
    const int n = dir ? 127 - step : step;
    f32x4 av[2], ao[2];
#pragma unroll
    for (int nt = 0; nt < 2; ++nt) {
      av[nt] = (f32x4){0.f, 0.f, 0.f, 0.f};
      ao[nt] = (f32x4){0.f, 0.f, 0.f, 0.f};
    }
#pragma unroll
    for (int ks = 0; ks < 4; ++ks)
#pragma unroll
      for (int nt = 0; nt < 2; ++nt) {
        bf16x8 sf = *(const bf16x8*)(St + (nt * 16 + l15) * 136 + ks * 32 + q4 * 8);
        av[nt] = MFMA16(cur.wf[ks], sf, av[nt]);
        ao[nt] = MFMA16(cur.qf[ks], sf, ao[nt]);
      }
#pragma unroll
    for (int nt = 0; nt < 2; ++nt) {
      *(u32x2*)(VnT + (nt * 16 + l15) * 72 + 16 * wave + q4 * 4) =
          pack4(bf2f(cur.u[nt][0]) - av[nt][0], bf2f(cur.u[nt][1]) - av[nt][1], bf2f(cur.u[nt][2]) - av[nt][2], bf2f(cur.u[nt][3]) - av[nt][3]);
    }
    __syncthreads();
    bf16x8 vf[2][2];
#pragma unroll
    for (int nt = 0; nt < 2; ++nt)
#pragma unroll
      for (int ks = 0; ks < 2; ++ks) vf[nt][ks] = *(const bf16x8*)(VnT + (nt * 16 + l15) * 72 + ks * 32 + q4 * 8);
#pragma unroll
    for (int ks = 0; ks < 2; ++ks)
#pragma unroll
      for (int nt = 0; nt < 2; ++nt) ao[nt] = MFMA16(cur.af[ks], vf[nt][ks], ao[nt]);
    {
      bf16_t* op = p.oc() + ((size_t)dir * NTOK + (size_t)b * S + n * 64 + 16 * wave + q4 * 4) * 512 + h * 128 + sl * 32 + l15;
#pragma unroll
      for (int nt = 0; nt < 2; ++nt)
#pragma unroll
        for (int i = 0; i < 4; ++i) op[i * 512 + nt * 16] = f2bf(ao[nt][i]);
    }
#pragma unroll
    for (int mt = 0; mt < 2; ++mt)
#pragma unroll
      for (int nt = 0; nt < 2; ++nt) {
        sacc[mt][nt] *= cur.egl;
#pragma unroll
        for (int ks = 0; ks < 2; ++ks) sacc[mt][nt] = MFMA16(cur.kf[mt][ks], vf[nt][ks], sacc[mt][nt]);
        *(u32x2*)(St + (nt * 16 + l15) * 136 + 32 * wave + mt * 16 + q4 * 4) =
            pack4(sacc[mt][nt][0], sacc[mt][nt][1], sacc[mt][nt][2], sacc[mt][nt][3]);
      }
    __syncthreads();
  };
  c2_load(p, RA, itembase + (dir ? 127 : 0), sl, wave, l15, q4);
#pragma unroll 1
  for (int step = 0; step < 128; step += 2) {
    c2_load(p, RB, itembase + (dir ? 126 - step : step + 1), sl, wave, l15, q4);
    do_step(RA, step);
    if (step + 2 < 128) c2_load(p, RA, itembase + (dir ? 125 - step : step + 2), sl, wave, l15, q4);
    do_step(RB, step + 1);
  }
  __builtin_amdgcn_s_setprio(0);
}

DI void p3b_rows(const Params& p, int l) {
  int tid_ = threadIdx.x;
  asm volatile("" : "+v"(tid_));
  int nb_ = gridDim.x;
  asm volatile("" : "+s"(nb_));
  const int tid = tid_, lane = tid & 63, wave = tid >> 6;
  const float lam = p.lam()[l], lam_init = p.lam()[4 + l];
  for (int row = blockIdx.x * 4 + wave; row < NTOK; row += nb_ * 4) {
#pragma unroll
    for (int br = 0; br < 2; ++br) {
      bf16_t* X0 = br ? p.oc() : p.ob0();
      const bf16_t* X1 = br ? (p.oc() + (size_t)NTOK * 512) : p.ob1();
      const bf16_t* Z = br ? p.zc() : p.zb();
      const float c1 = br ? 1.f : -lam;
      const float fac = br ? 1.f : (1.f - lam_init);
      const float* gv = (br ? p.c_norm_g : p.b_subln_g) + l * 128 + (lane & 15) * 8;
      const size_t off = (size_t)row * 512 + lane * 8;
      bf16x8 f = *(const bf16x8*)(X0 + off);
      bf16x8 bw = *(const bf16x8*)(X1 + off);
      bf16x8 z = *(const bf16x8*)(Z + off);
      float v[8];
      float sq = 0.f;
#pragma unroll
      for (int j = 0; j < 8; ++j) {
        v[j] = bfs(f[j]) + c1 * bfs(bw[j]);
        sq += v[j] * v[j];
      }
      sq += __shfl_xor(sq, 1);
      sq += __shfl_xor(sq, 2);
      sq += __shfl_xor(sq, 4);
      sq += __shfl_xor(sq, 8);
      const float rs = rsqrtf(sq * (1.f / 128.f) + 1e-6f) * fac;
      float t[8];
#pragma unroll
      for (int j = 0; j < 8; ++j) t[j] = v[j] * rs * gv[j] * bfs(z[j]);
      *(bf16x8*)(X0 + off) = pack8(t);
    }
  }
}

DI void p4_tile(const Params& p, int l, int m, int n, char* lds) {
  int tid_ = threadIdx.x;
  asm volatile("" : "+v"(tid_));
  const int tid = tid_, lane = tid & 63, wave = tid >> 6;
  const int wm = wave >> 1, wn = wave & 1, r = lane & 31, hh = lane >> 5;
  const int row_base = m * 128 + wm * 64, col_base = n * 128 + wn * 64;
  f32x16 acc[2][2];
#pragma unroll
  for (int a = 0; a < 2; ++a)
#pragma unroll
    for (int b = 0; b < 2; ++b) zero16(acc[a][b]);
#pragma unroll 1
  for (int br = 0; br < 3; ++br) {
    const bf16_t* A = (br == 0 ? p.oa() : (br == 1 ? p.ob0() : p.oc())) + (size_t)m * 128 * 512;
    const bf16_t* B = p.wt_bo() + ((size_t)(l * 3 + br) * 1024 + n * 128) * 512;
    gemm_loop(
        acc, [&](int row, int k, int) { return *(const bf16x8*)(A + (size_t)row * 512 + k); },
        [&](int row, int k) { return *(const bf16x8*)(B + (size_t)row * 512 + k); }, 8, lds, tid);
    bf16_t* g0 = (bf16_t*)lds;
    bf16_t* g1 = (bf16_t*)(lds + 34816);
    __syncthreads();
    {
      const bf16_t* gsrc = p.gate() + (size_t)(m * 128) * 3072 + br * 1024 + n * 128;
#pragma unroll
      for (int j = 0; j < 8; ++j) {
        const int c = tid + 256 * j;
        const int rr = c >> 4, cc = c & 15;
        *(bf16x8*)(g0 + rr * 136 + cc * 8) = *(const bf16x8*)(gsrc + (size_t)rr * 3072 + cc * 8);
        if (br < 2) *(bf16x8*)(g1 + rr * 136 + cc * 8) = *(const bf16x8*)(gsrc + (size_t)rr * 3072 + 1024 + cc * 8);
      }
    }
    __syncthreads();
    const int lbase = (wm * 64 + 4 * hh) * 136 + wn * 64 + r;
    if (br < 2) {
#pragma unroll
      for (int mt = 0; mt < 2; ++mt)
#pragma unroll
        for (int i = 0; i < 16; ++i)
#pragma unroll
          for (int nt = 0; nt < 2; ++nt) {
            const int o = lbase + (mt * 32 + (i & 3) + 8 * (i >> 2)) * 136 + nt * 32;
            acc[mt][nt][i] *= bf2f(g0[o]) * frcp(fmaxf(bf2f(g1[o]), 1e-20f));
          }
    } else {
#pragma unroll
      for (int mt = 0; mt < 2; ++mt)
#pragma unroll
        for (int i = 0; i < 16; ++i)
#pragma unroll
          for (int nt = 0; nt < 2; ++nt) {
            const int o = lbase + (mt * 32 + (i & 3) + 8 * (i >> 2)) * 136 + nt * 32;
            g1[o] = f2bf(acc[mt][nt][i] * bf2f(g0[o]));
          }
      __syncthreads();
      bf16_t* dstp = p.merged() + (size_t)(m * 128) * 1024 + n * 128;
#pragma unroll
      for (int j = 0; j < 8; ++j) {
        const int c = tid + 256 * j;
        const int rr = c >> 4, cc = c & 15;
        *(bf16x8*)(dstp + (size_t)rr * 1024 + cc * 8) = *(const bf16x8*)(g1 + rr * 136 + cc * 8);
      }
    }
  }
}

DI void p5_tile(const Params& p, int l, int m, int n, char* lds) {
  int tid_ = threadIdx.x;
  asm volatile("" : "+v"(tid_));
  const int tid = tid_, lane = tid & 63, wave = tid >> 6;
  const int wm = wave >> 1, wn = wave & 1, r = lane & 31, hh = lane >> 5;
  const int row_base = m * 128 + wm * 64, col_base = n * 128 + wn * 64;
  f32x16 acc[2][2];
#pragma unroll
  for (int a = 0; a < 2; ++a)
#pragma unroll
    for (int b = 0; b < 2; ++b) zero16(acc[a][b]);
  const bf16_t* A = p.merged() + (size_t)m * 128 * 1024;
  const bf16_t* B = p.wt_out() + ((size_t)l * 1024 + n * 128) * 1024;
  gemm_loop(
      acc, [&](int row, int k, int) { return *(const bf16x8*)(A + (size_t)row * 1024 + k); },
      [&](int row, int k) { return *(const bf16x8*)(B + (size_t)row * 1024 + k); }, 16, lds, tid);
  const float* xsrc = (l == 0) ? p.x : p.out;
  float* ct = (float*)lds;
  __syncthreads();
#pragma unroll
  for (int mt = 0; mt < 2; ++mt)
#pragma unroll
    for (int i = 0; i < 16; ++i)
#pragma unroll
      for (int nt = 0; nt < 2; ++nt)
        ct[(wm * 64 + mt * 32 + crow(i, hh)) * 132 + wn * 64 + nt * 32 + r] = acc[mt][nt][i];
  __syncthreads();
#pragma unroll
  for (int j = 0; j < 16; ++j) {
    const int rr = (tid >> 5) + 8 * j, c4 = (tid & 31) * 4;
    const size_t g = (size_t)(m * 128 + rr) * 1024 + n * 128 + c4;
    const float4 a = *(const float4*)(ct + rr * 132 + c4);
    float4 x = *(const float4*)(xsrc + g);
    x.x += a.x;
    x.y += a.y;
    x.z += a.z;
    x.w += a.w;
    *(float4*)(p.out + g) = x;
    *(u32x2*)(p.xb() + g) = pack4(x.x, x.y, x.z, x.w);
    float ss = x.x * x.x + x.y * x.y + x.z * x.z + x.w * x.w;
    ss += __shfl_xor(ss, 16);
    ss += __shfl_xor(ss, 8);
    ss += __shfl_xor(ss, 4);
    ss += __shfl_xor(ss, 2);
    ss += __shfl_xor(ss, 1);
    if ((tid & 31) == 0) atomicAdd(&p.rowss()[(size_t)(l + 1) * NTOK + m * 128 + rr], ss);
  }
}

DI void phase_final(const Params& p) {
  const size_t n4 = (size_t)NTOK * 256;
  int tid_ = threadIdx.x;
  asm volatile("" : "+v"(tid_));
  int nb_ = gridDim.x;
  asm volatile("" : "+s"(nb_));
  for (size_t i = (size_t)blockIdx.x * 256 + tid_; i < n4; i += (size_t)nb_ * 256) {
    const int row = (int)(i >> 8), c4 = (int)(i & 255);
    const float rs = rsqrtf(p.rowss()[(size_t)4 * NTOK + row] * (1.f / 1024.f) + 1e-6f);
    float4 v = ((const float4*)p.out)[i];
    const float4 g = ((const float4*)p.final_g)[c4];
    v.x *= rs * g.x;
    v.y *= rs * g.y;
    v.z *= rs * g.z;
    v.w *= rs * g.w;
    ((float4*)p.out)[i] = v;
  }
}


#define XB_XCNT(j) (64 * (j))
#define XB_XSUB(j) (1024 + 64 * (j))
#define XB_XGEN(j) (2048 + 64 * (j))
#define XB_TOP 3072
#define XB_TOPGEN 3136
#define XB_FLAT 3264
#define XB_WORDS 3328
DI unsigned xb_ld(unsigned* q) { return __hip_atomic_load(q, __ATOMIC_RELAXED, __HIP_MEMORY_SCOPE_AGENT); }
DI unsigned xb_add(unsigned* q, unsigned v) { return __hip_atomic_fetch_add(q, v, __ATOMIC_RELAXED, __HIP_MEMORY_SCOPE_AGENT); }
DI unsigned xcc_id() { return (unsigned)__builtin_amdgcn_s_getreg((3 << 11) | 20) & 0xFu; }
#define XB_SPIN(cond)                                   \
  do {                                                  \
    unsigned sp_ = 0;                                   \
    while (cond) {                                      \
      __builtin_amdgcn_s_sleep(1);                      \
      if (++sp_ > (1u << 24)) break;                    \
    }                                                   \
  } while (0)

#define LAS __attribute__((address_space(3)))
DI void gbar(unsigned* bar, volatile LAS unsigned* st) {
  asm volatile("s_waitcnt vmcnt(0)" ::: "memory");
  __syncthreads();
  if (threadIdx.x == 0) {
    __builtin_amdgcn_s_waitcnt(0);
    const unsigned nloc = st[0], nx = st[1], x = st[2];
    const unsigned old = xb_add(&bar[XB_XSUB(x)], 1u);
    const unsigned gen = old / nloc;
    if (old + 1u == (gen + 1u) * nloc) {
      __builtin_amdgcn_fence(__ATOMIC_RELEASE, "agent");
      asm volatile("s_waitcnt vmcnt(0)" ::: "memory");
      xb_add(&bar[XB_TOP], 1u);
    }
    XB_SPIN(xb_ld(&bar[XB_TOP]) < (gen + 1u) * nx);
    __builtin_amdgcn_fence(__ATOMIC_ACQUIRE, "agent");
    asm volatile("s_waitcnt vmcnt(0)" ::: "memory");
  }
  __syncthreads();
}

DI int next_item(unsigned* ctr, int n_per_q, int& qoff, unsigned xcc, volatile LAS int* s_item) {
  __syncthreads();
  if (threadIdx.x == 0) {
    int res = -1;
    while (qoff < 8) {
      const int q = (int)((xcc + (unsigned)qoff) & 7u);
      const int it = (int)atomicAdd(ctr + q * 16, 1u);
      if (it < n_per_q) {
        res = q * n_per_q + it;
        break;
      }
      ++qoff;
    }
    *s_item = res;
  }
  __syncthreads();
  return *s_item;
}

__global__ void __launch_bounds__(256, 2) mega(Params p) {
  __shared__ __attribute__((aligned(16))) char lds[LDS_TOTAL];
  __shared__ unsigned xst_s[4];
  __shared__ int s_item_s[4];
  volatile LAS unsigned* xst = (volatile LAS unsigned*)&xst_s[0];
  volatile LAS int* s_item = (volatile LAS int*)&s_item_s[0];
  cg::grid_group grid = cg::this_grid();
  const int bid = blockIdx.x, nb = gridDim.x;
  if (threadIdx.x == 0) {
    const unsigned x = xcc_id();
    xst[2] = x;
    xb_add(&p.bar()[XB_XCNT(x)], 1u);
  }
  for (int ph = p.ph0; ph < p.ph1; ++ph) {
    if (ph == 0) {
      if (PH_MASK & 1) phase0(p, lds);
    } else if (ph == N_PHASES - 1) {
      phase_final(p);
    } else {
      const int l = (ph - 1) / SLOTS, slot = (ph - 1) % SLOTS;
      int k = slot, cofs = 0, flags = 3;
      if (SLOTS == 7) {
        const int d = p.dup_k;
        if (d < 0) k = (slot < 6) ? slot : 99;
        else if (slot == d + 1) { k = d; cofs = 8; flags = p.dup_flags; }
        else if (slot > d + 1) k = slot - 1;
      }
      if (k == 0) {
        const int xc = bid & 7, cnt = (nb - xc + 7) >> 3;
        for (int j = bid >> 3; j < 9 * 128; j += cnt) {
          const int ng = j >> 7, r7 = j & 127;
          const int m = 16 * xc + 8 * (r7 >> 6) + (r7 & 7), n = 8 * ng + ((r7 & 63) >> 3);
          if (n < 67 && (PH_MASK & 2)) p1_tile(p, l, m, n, lds);
        }
      } else if (k == 1) {
        unsigned* ctr = p.qctr() + (l * 2 + cofs) * 128;
        const unsigned xcc = xst[2];
        int qoff = 0;
        for (;;) {
          const int it = next_item(ctr, 256, qoff, xcc, s_item);
          if (it < 0) break;
          const int q = it >> 8, i = it & 255;
          if (i < 128) {
            if (flags & 1) c1_item(p, l, q >> 2, q & 3, i, lds);
          } else {
            const int j = i - 128;
            if (flags & 2) aattn_item(p, l, q >> 2, (q & 1) * 32 + (j >> 2), ((q >> 1) & 1) * 4 + (j & 3), lds);
          }
        }
      } else if (k == 2) {
        unsigned* ctr = p.qctr() + (l * 2 + 1 + cofs) * 128;
        const unsigned xcc = xst[2];
        int qoff = 0;
        for (;;) {
          const int it = next_item(ctr, 223, qoff, xcc, s_item);
          if (it < 0) break;
          const int q = it / 223, i = it % 223;
          if (i >= 136) {
            int tid_ = threadIdx.x;
            asm volatile("" : "+v"(tid_));
            const int c0 = (q * 87 + (i - 136)) * 4;
            for (int c = c0; c < c0 + 4; ++c) {
              int t;
              if (c < 384) t = 8576 + l * 384 + c;
              else if (c < 640) t = 10112 + l * 256 + (c - 384);
              else t = (l < 3) ? (l + 1) * 2144 + (c - 640) : -1;
              if (t >= 0) do_wtile(p, t, (float*)lds, tid_);
            }
          } else if (i < 8) {
            if (flags & 1) c2_item(p, q >> 2, q & 3, (i >> 2) & 1, i & 3, lds);
          } else {
            const int j = i - 8;
            if (flags & 2) battn_item(p, l, q >> 2, q & 3, j >> 1, j & 1, lds);
          }
        }
      } else if (k == 3) {
        if (PH_MASK & 64) p3b_rows(p, l);
      } else if (k == 4) {
        const int xc = bid & 7, cnt = (nb - xc + 7) >> 3;
        for (int j = bid >> 3; j < 128; j += cnt) if (PH_MASK & 64) p4_tile(p, l, 16 * xc + (j >> 3), j & 7, lds);
      } else if (k == 5) {
        const int xc = bid & 7, cnt = (nb - xc + 7) >> 3;
        for (int j = bid >> 3; j < 128; j += cnt) if (PH_MASK & 128) p5_tile(p, l, 16 * xc + (j >> 3), j & 7, lds);
      }
    }
    if (ph + 1 < p.ph1) {
      if (ph == p.ph0) {
        if (p.ph1 > 100000) grid.sync();
        asm volatile("s_waitcnt vmcnt(0)" ::: "memory");
        __syncthreads();
        if (threadIdx.x == 0) {
          __builtin_amdgcn_fence(__ATOMIC_RELEASE, "agent");
          asm volatile("s_waitcnt vmcnt(0)" ::: "memory");
          xb_add(&p.bar()[XB_FLAT], 1u);
          XB_SPIN(xb_ld(&p.bar()[XB_FLAT]) < (unsigned)nb);
          __builtin_amdgcn_fence(__ATOMIC_ACQUIRE, "agent");
          asm volatile("s_waitcnt vmcnt(0)" ::: "memory");
        }
        if (threadIdx.x == 0) {
          unsigned cnt = 0, mine = 0;
          const unsigned x = xst[2];
          for (unsigned j = 0; j < 16; ++j) {
            const unsigned c = xb_ld(&p.bar()[XB_XCNT(j)]);
            cnt += (c > 0u) ? 1u : 0u;
            mine = (j == x) ? c : mine;
          }
          xst[0] = mine > 0u ? mine : 1u;
          xst[1] = cnt > 0u ? cnt : 1u;
        }
        __syncthreads();
      } else {
        gbar(p.bar(), xst);
      }
    }
  }
}

extern "C" void kernel_launch(void* const* d_in, const int* in_sizes, int n_in, void* d_out, int out_size, void* d_ws,
                              size_t ws_size, hipStream_t stream) {
  static int grid_blocks = 0;
  if (!grid_blocks) {
    int dev = 0, cus = 0, per_cu = 0;
    hipGetDevice(&dev);
    hipDeviceGetAttribute(&cus, hipDeviceAttributeMultiprocessorCount, dev);
    hipOccupancyMaxActiveBlocksPerMultiprocessor(&per_cu, mega, 256, 0);
    if (per_cu > 2) per_cu = 2;
    if (per_cu < 1) per_cu = 1;
    grid_blocks = cus * per_cu;
  }
  Params p{};
  p.x = (const float*)d_in[0];
  p.norm_g = (const float*)d_in[1];
  p.w_in = (const float*)d_in[2];
  p.a_sink = (const float*)d_in[3];
  p.b_lambda = (const float*)d_in[4];
  p.b_subln_g = (const float*)d_in[5];
  p.c_conv_w = (const float*)d_in[6];
  p.c_a_log = (const float*)d_in[7];
  p.c_dt_bias = (const float*)d_in[8];
  p.c_norm_g = (const float*)d_in[9];
  p.w_bo_a = (const float*)d_in[10];
  p.w_bo_b = (const float*)d_in[11];
  p.w_bo_c = (const float*)d_in[12];
  p.w_out = (const float*)d_in[13];
  p.final_g = (const float*)d_in[14];
  p.out = (float*)d_out;

  p.ws = (char*)d_ws;
  if (grid_blocks > MAX_GRID) grid_blocks = MAX_GRID;
  if (WS_TOTAL > ws_size) fprintf(stderr, "workspace too small: need %zu have %zu\n", (size_t)WS_TOTAL, ws_size);
  p.ph0 = 0;
  p.ph1 = N_PHASES;
  p.dup_k = DUP_K;
  p.dup_flags = DUP_FLAGS;
  hipMemsetAsync((char*)d_ws + OFF_BAR, 0, 32768, stream);
  void* args[] = {&p};
  hipError_t e = hipLaunchCooperativeKernel((void*)mega, dim3(grid_blocks), dim3(256), args, 0, stream);
  if (e != hipSuccess) fprintf(stderr, "cooperative launch failed: %s (grid %d)\n", hipGetErrorString(e), grid_blocks);
}
```

```cpp
#include <hip/hip_runtime.h>
#include <hip/hip_cooperative_groups.h>
#include <stdint.h>
#include <stdio.h>
namespace cg = cooperative_groups;

#define DI __device__ __forceinline__
typedef unsigned short bf16_t;
typedef __attribute__((ext_vector_type(8))) short bf16x8;
typedef __attribute__((ext_vector_type(16))) float f32x16;
typedef __attribute__((ext_vector_type(4))) float f32x4;
typedef __attribute__((ext_vector_type(2))) unsigned u32x2;
typedef __attribute__((ext_vector_type(4))) unsigned u32x4;
typedef __bf16 bf2_t __attribute__((ext_vector_type(2)));
typedef float f2_t __attribute__((ext_vector_type(2)));

#define MFMA32(a, b, c) __builtin_amdgcn_mfma_f32_32x32x16_bf16((a), (b), (c), 0, 0, 0)
#define MFMA16(a, b, c) __builtin_amdgcn_mfma_f32_16x16x32_bf16((a), (b), (c), 0, 0, 0)

constexpr int S = 8192;
constexpr int NTOK = 16384;
constexpr int DINP = 8576;
constexpr float LOG2E = 1.4426950408889634f;
constexpr float QSCALE = 0.125f * 1.4426950408889634f;
constexpr int LDS_MAIN = 75776;
constexpr int LDS_TOTAL = LDS_MAIN + 1072;
#ifndef SLOTS
#define SLOTS 6
#endif
#ifndef DUP_K
#define DUP_K -1
#endif
#ifndef DUP_FLAGS
#define DUP_FLAGS 3
#endif
constexpr int N_PHASES = 2 + 4 * SLOTS;
#ifndef PH_MASK
#define PH_MASK 0xff
#endif

constexpr size_t MBY = 1024 * 1024;
constexpr size_t OFF_WT_IN = 0;
constexpr size_t OFF_WT_BO = OFF_WT_IN + (size_t)4 * DINP * 1024 * 2;
constexpr size_t OFF_WT_OUT = OFF_WT_BO + (size_t)12 * 1024 * 512 * 2;
constexpr size_t OFF_ROWSS = OFF_WT_OUT + (size_t)4 * 1024 * 1024 * 2;
constexpr size_t OFF_ROPEC = OFF_ROWSS + (size_t)5 * NTOK * 4;
constexpr size_t OFF_ROPES = OFF_ROPEC + (size_t)S * 32 * 4;
constexpr size_t OFF_LAM = OFF_ROPES + (size_t)S * 32 * 4;
constexpr size_t OFF_CTR = OFF_LAM + 256;
constexpr size_t OFF_EGL = OFF_CTR + 256;
constexpr size_t OFF_BAR = OFF_EGL + 8192;
constexpr size_t OFF_QCTR = OFF_BAR + 16384;
constexpr size_t OFF_XB = OFF_QCTR + 16384;
constexpr size_t OFF_QB = OFF_XB + 32 * MBY;
constexpr size_t OFF_KB = OFF_QB + 16 * MBY;
constexpr size_t OFF_VBT = OFF_KB + 16 * MBY;
constexpr size_t OFF_ZB = OFF_VBT + 16 * MBY;
constexpr size_t OFF_ZC = OFF_ZB + 16 * MBY;
constexpr size_t OFF_GATE = OFF_ZC + 16 * MBY;
constexpr size_t OFF_OA = OFF_GATE + 96 * MBY;
constexpr size_t OFF_SHORT = OFF_OA + 16 * MBY;
constexpr size_t OFF_CQD = OFF_SHORT + 89 * MBY;
constexpr size_t OFF_CW = OFF_CQD + 32 * MBY;
constexpr size_t OFF_CKT = OFF_CW + 32 * MBY;
constexpr size_t OFF_CATTN = OFF_CKT + 32 * MBY;
constexpr size_t WS_TOTAL = OFF_CATTN + 16 * MBY;
constexpr int MAX_GRID = 640;

struct Params {
  const float *x, *norm_g, *w_in, *a_sink, *b_lambda, *b_subln_g, *c_conv_w, *c_a_log, *c_dt_bias, *c_norm_g,
      *w_bo_a, *w_bo_b, *w_bo_c, *w_out, *final_g;
  float* out;
  char* ws;
  int ph0, ph1, dup_k, dup_flags;
#define WSP(name, type, off) DI type* name() const { return (type*)(ws + (off)); }
  WSP(wt_in, bf16_t, OFF_WT_IN) WSP(wt_bo, bf16_t, OFF_WT_BO) WSP(wt_out, bf16_t, OFF_WT_OUT)
  WSP(rowss, float, OFF_ROWSS) WSP(ropec, float, OFF_ROPEC) WSP(ropes, float, OFF_ROPES)
  WSP(lam, float, OFF_LAM) WSP(ctr, unsigned, OFF_CTR) WSP(c_egl, float, OFF_EGL) WSP(bar, unsigned, OFF_BAR) WSP(qctr, unsigned, OFF_QCTR)
  WSP(xb, bf16_t, OFF_XB) WSP(c_u, bf16_t, OFF_XB)
  WSP(qb, bf16_t, OFF_QB) WSP(kb, bf16_t, OFF_KB) WSP(vbt, bf16_t, OFF_VBT) WSP(zb, bf16_t, OFF_ZB)
  WSP(zc, bf16_t, OFF_ZC) WSP(gate, bf16_t, OFF_GATE) WSP(oa, bf16_t, OFF_OA)
  WSP(cqkv, bf16_t, OFF_SHORT) WSP(qa, bf16_t, OFF_SHORT + 48 * MBY) WSP(ka, bf16_t, OFF_SHORT + 64 * MBY)
  WSP(vat, bf16_t, OFF_SHORT + 68 * MBY) WSP(za, bf16_t, OFF_SHORT + 72 * MBY) WSP(betag, float, OFF_SHORT + 88 * MBY)
  WSP(ob0, bf16_t, OFF_SHORT) WSP(oc, bf16_t, OFF_SHORT + 16 * MBY) WSP(ob1, bf16_t, OFF_SHORT + 48 * MBY)
  WSP(c_qd, bf16_t, OFF_CQD) WSP(merged, bf16_t, OFF_CQD) WSP(c_w, bf16_t, OFF_CW) WSP(c_kt, bf16_t, OFF_CKT)
  WSP(c_attn, bf16_t, OFF_CATTN)
#undef WSP
};

__constant__ float kInvFreq[32] = {
    0x1.0000000000000p+0f, 0x1.7ff2220000000p-1f, 0x1.1feb340000000p-1f, 0x1.afd1360000000p-2f,
    0x1.43d1360000000p-2f, 0x1.e5a84a0000000p-3f, 0x1.6c310e0000000p-3f, 0x1.111aee0000000p-3f,
    0x1.99999a0000000p-4f, 0x1.33281a0000000p-4f, 0x1.ccab840000000p-5f, 0x1.59742a0000000p-5f,
    0x1.030dc60000000p-5f, 0x1.84869e0000000p-6f, 0x1.235a720000000p-6f, 0x1.b4f7e40000000p-7f,
    0x1.47ae140000000p-7f, 0x1.eb73600000000p-8f, 0x1.7089380000000p-8f, 0x1.145cee0000000p-8f,
    0x1.9e7c700000000p-9f, 0x1.36d21a0000000p-9f, 0x1.d22a500000000p-10f, 0x1.5d931c0000000p-10f,
    0x1.0624de0000000p-10f, 0x1.8929180000000p-11f, 0x1.26d42c0000000p-11f, 0x1.ba2e4e0000000p-12f,
    0x1.4b96c00000000p-12f, 0x1.f1502a0000000p-13f, 0x1.74eea60000000p-13f, 0x1.17a8e40000000p-13f};

DI unsigned pack2(float a, float b) {
  f2_t v = {a, b};
  bf2_t r = __builtin_convertvector(v, bf2_t);
  return __builtin_bit_cast(unsigned, r);
}
DI bf16_t f2bf(float a) {
  __bf16 r = (__bf16)a;
  return __builtin_bit_cast(bf16_t, r);
}
DI float bf2f(bf16_t u) { return __uint_as_float(((unsigned)u) << 16); }
DI float bfs(short u) { return __uint_as_float(((unsigned)(unsigned short)u) << 16); }
DI bf16x8 pack8(const float* t) {
  u32x4 u = {pack2(t[0], t[1]), pack2(t[2], t[3]), pack2(t[4], t[5]), pack2(t[6], t[7])};
  return __builtin_bit_cast(bf16x8, u);
}
DI u32x2 pack4(float a, float b, float c, float d) {
  u32x2 u = {pack2(a, b), pack2(c, d)};
  return u;
}
DI int crow(int i, int h) { return (i & 3) + 8 * (i >> 2) + 4 * h; }
DI float wave_sum(float v) {
#pragma unroll
  for (int o = 32; o > 0; o >>= 1) v += __shfl_xor(v, o);
  return v;
}
DI float ex2(float a) { return __builtin_amdgcn_exp2f(a); }
DI float frcp(float a) { return __builtin_amdgcn_rcpf(a); }
DI float frsq(float a) { return __builtin_amdgcn_rsqf(a); }
DI float silu_f(float a) { return a * frcp(1.f + ex2(-1.4426950408889634f * a)); }
DI float sigmoid_f(float a) { return frcp(1.f + ex2(-1.4426950408889634f * a)); }
DI void zero16(f32x16& a) {
#pragma unroll
  for (int i = 0; i < 16; ++i) a[i] = 0.f;
}

DI void sincos_red(float ang, float& s, float& c) {
  double a = (double)ang;
  double q = rint(a * 0.63661977236758134308);
  double rr = fma(-q, 1.57079632679489655800, a);
  rr = fma(-q, 6.12323399573676603587e-17, rr);
  double r2 = rr * rr;
  double sp = rr * (1.0 + r2 * (-1.0 / 6.0 + r2 * (1.0 / 120.0 + r2 * (-1.0 / 5040.0 + r2 * (1.0 / 362880.0 +
              r2 * (-1.0 / 39916800.0 + r2 * (1.0 / 6227020800.0)))))));
  double cp = 1.0 + r2 * (-0.5 + r2 * (1.0 / 24.0 + r2 * (-1.0 / 720.0 + r2 * (1.0 / 40320.0 +
              r2 * (-1.0 / 3628800.0 + r2 * (1.0 / 479001600.0 + r2 * (-1.0 / 87178291200.0)))))));
  int qi = ((int)q) & 3;
  double ss = (qi & 1) ? cp : sp, cc = (qi & 1) ? sp : cp;
  if (qi == 1) cc = -cc;
  else if (qi == 2) { ss = -ss; cc = -cc; }
  else if (qi == 3) ss = -ss;
  s = (float)ss;
  c = (float)cc;
}

DI int inmap(int n) { return n < 5376 ? n : (n < 8448 ? n + 16 : (n < 8464 ? n - 8448 + 5376 : -1)); }

template <class AL, class BL>
DI void gemm_loop(f32x16 (&acc)[2][2], AL aload, BL bload, int nslab, char* lds, const int tid) {
  const int lane = tid & 63, wave = tid >> 6;
  const int wm = wave >> 1, wn = wave & 1, r = lane & 31, hh = lane >> 5;
  const int lrow = tid >> 3, kc = tid & 7;
  bf16_t* la = (bf16_t*)lds;
  bf16_t* lb = (bf16_t*)(lds + 36864);
  bf16x8 ra0[4], rb0[4], ra1[4], rb1[4];
  auto gl = [&](bf16x8 (&ra)[4], bf16x8 (&rb)[4], int s) {
#pragma unroll
    for (int i = 0; i < 4; ++i) {
      ra[i] = aload(lrow + 32 * i, s * 64 + kc * 8, i);
      rb[i] = bload(lrow + 32 * i, s * 64 + kc * 8);
    }
  };
  auto st = [&](const bf16x8 (&ra)[4], const bf16x8 (&rb)[4], int s) {
    bf16_t* A2 = la + (s & 1) * (128 * 72);
    bf16_t* B2 = lb + (s & 1) * (128 * 72);
#pragma unroll
    for (int i = 0; i < 4; ++i) {
      *(bf16x8*)(A2 + (lrow + 32 * i) * 72 + kc * 8) = ra[i];
      *(bf16x8*)(B2 + (lrow + 32 * i) * 72 + kc * 8) = rb[i];
    }
  };
  auto compute = [&](int s) {
    const bf16_t* A = la + (s & 1) * (128 * 72);
    const bf16_t* B = lb + (s & 1) * (128 * 72);
    __builtin_amdgcn_s_setprio(1);
#pragma unroll
    for (int ks = 0; ks < 4; ++ks) {
      bf16x8 af[2], bfr[2];
#pragma unroll
      for (int mt = 0; mt < 2; ++mt) af[mt] = *(const bf16x8*)(A + (wm * 64 + mt * 32 + r) * 72 + ks * 16 + hh * 8);
#pragma unroll
      for (int nt = 0; nt < 2; ++nt) bfr[nt] = *(const bf16x8*)(B + (wn * 64 + nt * 32 + r) * 72 + ks * 16 + hh * 8);
#pragma unroll
      for (int mt = 0; mt < 2; ++mt)
#pragma unroll
        for (int nt = 0; nt < 2; ++nt) acc[mt][nt] = MFMA32(af[mt], bfr[nt], acc[mt][nt]);
    }
    __builtin_amdgcn_s_setprio(0);
  };
  gl(ra0, rb0, 0);
  if (nslab > 1) gl(ra1, rb1, 1);
  __syncthreads();
  st(ra0, rb0, 0);
  for (int s = 0; s < nslab; s += 2) {
    __syncthreads();
    st(ra1, rb1, s + 1);
    if (s + 2 < nslab) gl(ra0, rb0, s + 2);
    compute(s);
    __syncthreads();
    if (s + 2 < nslab) st(ra0, rb0, s + 2);
    if (s + 3 < nslab) gl(ra1, rb1, s + 3);
    compute(s + 1);
  }
}

template <class CM>
DI void transpose_tile(const float* src, int ld_src, int k0, int n0, CM colmap, const float* kscale, bf16_t* dst,
                       int ld_dst, float* tl, const int tid) {
  __syncthreads();
  {
    const int nn = tid & 63, kq = tid >> 6;
    const int oc = colmap(n0 + nn);
    const float* sp = src + (size_t)(k0 + kq) * ld_src + (oc >= 0 ? oc : 0);
    float v[16];
#pragma unroll
    for (int j = 0; j < 16; ++j) v[j] = sp[(size_t)(4 * j) * ld_src];
#pragma unroll
    for (int j = 0; j < 16; ++j) {
      float x = oc >= 0 ? v[j] : 0.f;
      if (kscale) x *= kscale[k0 + kq + 4 * j];
      tl[(kq + 4 * j) * 65 + nn] = x;
    }
  }
  __syncthreads();
  for (int i = tid; i < 512; i += 256) {
    int nn = i >> 3, kg = i & 7;
    float t[8];
#pragma unroll
    for (int j = 0; j < 8; ++j) t[j] = tl[(kg * 8 + j) * 65 + nn];
    *(bf16x8*)(dst + (size_t)(n0 + nn) * ld_dst + k0 + kg * 8) = pack8(t);
  }
}

DI void phase0(const Params& p, char* lds) {
  int tid_ = threadIdx.x;
  asm volatile("" : "+v"(tid_));
  int nb_ = gridDim.x;
  asm volatile("" : "+s"(nb_));
  const int tid = tid_, bid = blockIdx.x, nb = nb_;
  const int gtid = bid * 256 + tid, gsz = nb * 256;
  for (int i = gtid; i < 4 * NTOK; i += gsz) p.rowss()[NTOK + i] = 0.f;
  if (bid == 0 && tid < 64) p.ctr()[tid] = 0u;
  if (bid == 0 && tid < 4) {
    const int l = tid;
    const float* bl = p.b_lambda + l * 256;
    float s1 = 0.f, s2 = 0.f;
    for (int j = 0; j < 64; ++j) {
      s1 += bl[j] * bl[64 + j];
      s2 += bl[128 + j] * bl[192 + j];
    }
    float lam_init = 0.8f - 0.6f * expf(-0.3f * (float)l);
    p.lam()[l] = expf(s1) - expf(s2) + lam_init;
    p.lam()[4 + l] = lam_init;
  }
  for (int i = gtid; i < S * 32; i += gsz) {
    int pos = i >> 5, j = i & 31;
    float ang = (float)pos * kInvFreq[j];
    float s, c;
    sincos_red(ang, s, c);
    p.ropec()[i] = c;
    p.ropes()[i] = s;
  }
  {
    const int lane = tid & 63;
    const int gw = bid * 4 + (tid >> 6);
    for (int row = gw; row < NTOK; row += nb * 4) {
      const float4* src = (const float4*)(p.x + (size_t)row * 1024);
      float ss = 0.f;
#pragma unroll
      for (int i = 0; i < 4; ++i) {
        float4 v = src[lane + 64 * i];
        ss += v.x * v.x + v.y * v.y + v.z * v.z + v.w * v.w;
        *(u32x2*)(p.xb() + (size_t)row * 1024 + (lane + 64 * i) * 4) = pack4(v.x, v.y, v.z, v.w);
      }
      ss = wave_sum(ss);
      if (lane == 0) p.rowss()[row] = ss;
    }
  }
  float* tl = (float*)lds;
  auto ident = [](int n) { return n; };
  for (int t = bid; t < 11136; t += nb) {
    if (t < 8576) {
      int l = t / 2144, rem = t % 2144;
      int kt = rem / 134, nt = rem % 134;
      transpose_tile(p.w_in + (size_t)l * 1024 * 8464, 8464, kt * 64, nt * 64, inmap, p.norm_g + l * 1024,
                     p.wt_in() + (size_t)l * DINP * 1024, 1024, tl, tid);
    } else if (t < 10112) {
      int u = t - 8576;
      int mat = u >> 7, rem = u & 127;
      int l = mat / 3, br = mat % 3;
      int kt = rem >> 4, nt = rem & 15;
      const float* src = (br == 0 ? p.w_bo_a : (br == 1 ? p.w_bo_b : p.w_bo_c)) + (size_t)l * 512 * 1024;
      transpose_tile(src, 1024, kt * 64, nt * 64, ident, (const float*)nullptr, p.wt_bo() + (size_t)mat * 1024 * 512, 512, tl, tid);
    } else {
      int u = t - 10112;
      int l = u >> 8, rem = u & 255;
      int kt = rem >> 4, nt = rem & 15;
      transpose_tile(p.w_out + (size_t)l * 1024 * 1024, 1024, kt * 64, nt * 64, ident, (const float*)nullptr,
                     p.wt_out() + (size_t)l * 1024 * 1024, 1024, tl, tid);
    }
  }
}

DI void p1_tile(const Params& p, int l, int m, int n, char* lds) {
  int tid_ = threadIdx.x;
  asm volatile("" : "+v"(tid_));
  const int tid = tid_, lane = tid & 63, wave = tid >> 6;
  const int wm = wave >> 1, wn = wave & 1, r = lane & 31, hh = lane >> 5;
  f32x16 acc[2][2];
#pragma unroll
  for (int a = 0; a < 2; ++a)
#pragma unroll
    for (int b = 0; b < 2; ++b) zero16(acc[a][b]);
  const bf16_t* A = p.xb() + (size_t)(m * 128) * 1024;
  const bf16_t* B = p.wt_in() + ((size_t)l * DINP + n * 128) * 1024;
  float* rsl = (float*)(lds + LDS_MAIN);
  if (tid < 128) rsl[tid] = frsq(p.rowss()[(size_t)l * NTOK + m * 128 + tid] * (1.f / 1024.f) + 1e-6f);
  gemm_loop(
      acc, [&](int row, int k, int) { return *(const bf16x8*)(A + (size_t)row * 1024 + k); },
      [&](int row, int k) { return *(const bf16x8*)(B + (size_t)row * 1024 + k); }, 16, lds, tid);

  const int colb = n * 128;
  const float* rss = p.rowss() + (size_t)l * NTOK;
  if (colb >= 8448) {
    if (wn == 0 && r < 16) {
#pragma unroll
      for (int mt = 0; mt < 2; ++mt)
#pragma unroll
        for (int i = 0; i < 16; ++i) {
          const int row = m * 128 + wm * 64 + mt * 32 + crow(i, hh);
          const float v = acc[mt][0][i] * rsqrtf(rss[row] * (1.f / 1024.f) + 1e-6f);
          float o;
          if (r < 8) o = sigmoid_f(v);
          else {
            const int jj = r - 8;
            const float xx = v + p.c_dt_bias[l * 8 + jj];
            const float sp = fmaxf(xx, 0.f) + __logf(1.f + __expf(-fabsf(xx)));
            o = -__expf(p.c_a_log[l * 8 + jj]) * sp;
          }
          p.betag()[(size_t)row * 16 + r] = o;
        }
    }
    return;
  }
  int mode;
  bf16_t* dst;
  int ld, cl0;
  float scale = 1.f;
  const int bb = (m * 128) >> 13, s0 = (m * 128) & (S - 1);
  if (colb < 512) { mode = 3; dst = p.qa(); ld = 512; cl0 = colb; scale = QSCALE; }
  else if (colb < 640) { mode = 3; dst = p.ka(); ld = 128; cl0 = colb - 512; }
  else if (colb < 768) { mode = 4; dst = p.vat() + ((size_t)bb * 128) * S + s0; ld = S; cl0 = 0; }
  else if (colb < 1280) { mode = 1; dst = p.za(); ld = 512; cl0 = colb - 768; }
  else if (colb < 1792) { mode = 3; dst = p.qb(); ld = 512; cl0 = colb - 1280; scale = QSCALE; }
  else if (colb < 2304) { mode = 3; dst = p.kb(); ld = 512; cl0 = colb - 1792; }
  else if (colb < 2816) { mode = 4; dst = p.vbt() + ((size_t)(bb * 4 + ((colb - 2304) >> 7)) * 128) * S + s0; ld = S; cl0 = 0; }
  else if (colb < 3328) { mode = 1; dst = p.zb(); ld = 512; cl0 = colb - 2816; }
  else if (colb < 4864) { mode = 0; dst = p.cqkv(); ld = 1536; cl0 = colb - 3328; }
  else if (colb < 5376) { mode = 1; dst = p.zc(); ld = 512; cl0 = colb - 4864; }
  else { mode = 2; dst = p.gate(); ld = 3072; cl0 = colb - 5376; }
  bf16_t* ct = (bf16_t*)lds;
  __syncthreads();
#pragma unroll
  for (int mt = 0; mt < 2; ++mt)
#pragma unroll
    for (int i = 0; i < 16; ++i) {
      const float rs = rsl[wm * 64 + mt * 32 + crow(i, hh)];
      acc[mt][0][i] *= rs;
      acc[mt][1][i] *= rs;
    }
  const int cl = wn * 64 + r;
  bf16_t* cw = ct + (wm * 64 + 4 * hh) * 136 + cl;
  if (mode == 4) {
#pragma unroll
    for (int mt = 0; mt < 2; ++mt)
#pragma unroll
      for (int ig = 0; ig < 4; ++ig) {
        const int rl0 = wm * 64 + mt * 32 + 8 * ig + 4 * hh;
        *(u32x2*)(ct + cl * 136 + rl0) = pack4(acc[mt][0][ig * 4], acc[mt][0][ig * 4 + 1], acc[mt][0][ig * 4 + 2], acc[mt][0][ig * 4 + 3]);
        *(u32x2*)(ct + (cl + 32) * 136 + rl0) = pack4(acc[mt][1][ig * 4], acc[mt][1][ig * 4 + 1], acc[mt][1][ig * 4 + 2], acc[mt][1][ig * 4 + 3]);
      }
  } else if (mode == 3) {
#pragma unroll
    for (int mt = 0; mt < 2; ++mt)
#pragma unroll
      for (int i = 0; i < 16; ++i) {
        const int rloc = mt * 32 + (i & 3) + 8 * (i >> 2);
        const int pos = s0 + wm * 64 + 4 * hh + rloc;
        const float c = p.ropec()[pos * 32 + r], s = p.ropes()[pos * 32 + r];
        const float v0 = acc[mt][0][i], v1 = acc[mt][1][i];
        cw[rloc * 136] = f2bf((v0 * c - v1 * s) * scale);
        cw[rloc * 136 + 32] = f2bf((v1 * c + v0 * s) * scale);
      }
  } else if (mode == 2) {
#pragma unroll
    for (int mt = 0; mt < 2; ++mt)
#pragma unroll
      for (int i = 0; i < 16; ++i) {
        const int rloc = mt * 32 + (i & 3) + 8 * (i >> 2);
        cw[rloc * 136] = f2bf(sigmoid_f(acc[mt][0][i]));
        cw[rloc * 136 + 32] = f2bf(sigmoid_f(acc[mt][1][i]));
      }
  } else if (mode == 1) {
#pragma unroll
    for (int mt = 0; mt < 2; ++mt)
#pragma unroll
      for (int i = 0; i < 16; ++i) {
        const int rloc = mt * 32 + (i & 3) + 8 * (i >> 2);
        cw[rloc * 136] = f2bf(silu_f(acc[mt][0][i]));
        cw[rloc * 136 + 32] = f2bf(silu_f(acc[mt][1][i]));
      }
  } else {
#pragma unroll
    for (int mt = 0; mt < 2; ++mt)
#pragma unroll
      for (int i = 0; i < 16; ++i) {
        const int rloc = mt * 32 + (i & 3) + 8 * (i >> 2);
        cw[rloc * 136] = f2bf(acc[mt][0][i]);
        cw[rloc * 136 + 32] = f2bf(acc[mt][1][i]);
      }
  }
  __syncthreads();
#pragma unroll
  for (int j = 0; j < 8; ++j) {
    const int c = tid + 256 * j;
    const int rr = c >> 4, cc = c & 15;
    const bf16x8 v = *(const bf16x8*)(ct + rr * 136 + cc * 8);
    if (mode == 4) *(bf16x8*)(dst + (size_t)rr * S + cc * 8) = v;
    else *(bf16x8*)(dst + (size_t)(m * 128 + rr) * ld + cl0 + cc * 8) = v;
  }
}

template <int DV, bool WIN>
DI void attn_core(f32x16 (&o)[DV / 32], float& m_run, float& l_run, const bf16x8 (&qf)[4], const bf16_t* kptr, int ldk,
                  const bf16_t* vtptr, int kt0, int kt1, int qpos, char* lds, const int tid) {
  constexpr int NV = DV / 32;
  constexpr int KS_BYTES = 64 * 72 * 2;
  constexpr int BUF = KS_BYTES + 128 * 72 * 2;
  const int lane = tid & 63;
  const int r = lane & 31, hh = lane >> 5;
  const int lrow = tid >> 3, kc = tid & 7;
  bf16x8 kreg[2], vreg[NV];
  auto gload = [&](int kt) {
#pragma unroll
    for (int i = 0; i < 2; ++i) kreg[i] = *(const bf16x8*)(kptr + (size_t)(kt * 64 + lrow + 32 * i) * ldk + kc * 8);
#pragma unroll
    for (int i = 0; i < NV; ++i) vreg[i] = *(const bf16x8*)(vtptr + (size_t)(lrow + 32 * i) * S + kt * 64 + kc * 8);
  };
  auto lstore = [&](int buf) {
    char* base = lds + buf * BUF;
#pragma unroll
    for (int i = 0; i < 2; ++i) *(bf16x8*)(base + ((lrow + 32 * i) * 72 + kc * 8) * 2) = kreg[i];
#pragma unroll
    for (int i = 0; i < NV; ++i) {
      u32x4 v = __builtin_bit_cast(u32x4, vreg[i]);
      char* d = base + KS_BYTES + (lrow + 32 * i) * 144 + (kc >> 1) * 32 + (kc & 1) * 8;
      u32x2 lo = {v.x, v.y}, hi = {v.z, v.w};
      *(u32x2*)d = lo;
      *(u32x2*)(d + 16) = hi;
    }
  };
  __syncthreads();
  gload(kt0);
  lstore(0);
  f32x16 minit;
#pragma unroll
  for (int i = 0; i < 16; ++i) minit[i] = -m_run;
  bool first = !WIN;
  for (int kt = kt0; kt < kt1; ++kt) {
    const int buf = (kt - kt0) & 1;
    const bool more = (kt + 1 < kt1);
    if (more) gload(kt + 1);
    __syncthreads();
    const char* base = lds + buf * BUF;
    const bf16_t* Ks = (const bf16_t*)base;
    const bf16_t* Vs = (const bf16_t*)(base + KS_BYTES);
    bf16x8 kf[4][2];
#pragma unroll
    for (int ks = 0; ks < 4; ++ks)
#pragma unroll
      for (int t = 0; t < 2; ++t) kf[ks][t] = *(const bf16x8*)(Ks + (t * 32 + r) * 72 + ks * 16 + hh * 8);
#pragma unroll
    for (int ks = 0; ks < 4; ++ks)
#pragma unroll
      for (int t = 0; t < 2; ++t) asm volatile("" : "+v"(kf[ks][t]));
    f32x16 s[2];
#pragma unroll
    for (int t = 0; t < 2; ++t) {
      s[t] = MFMA32(kf[0][t], qf[0], minit);
#pragma unroll
      for (int ks = 1; ks < 4; ++ks) s[t] = MFMA32(kf[ks][t], qf[ks], s[t]);
    }
    auto vread = [&](int g, int mt) {
      return *(const bf16x8*)(Vs + (mt * 32 + r) * 72 + g * 16 + 8 * hh);
    };
    bf16x8 vcur[NV], vnxt[NV];
#pragma unroll
    for (int mt = 0; mt < NV; ++mt) vcur[mt] = vread(0, mt);
    if (WIN) {
#pragma unroll
      for (int t = 0; t < 2; ++t)
#pragma unroll
        for (int i = 0; i < 16; ++i) {
          int d = kt * 64 + t * 32 + crow(i, hh) - qpos;
          if (d > 128 || d < -128) s[t][i] = -1e30f;
        }
    }
    float mx = s[0][0];
#pragma unroll
    for (int t = 0; t < 2; ++t)
#pragma unroll
      for (int i = 0; i < 16; ++i) mx = fmaxf(mx, s[t][i]);
    {
      auto rr = __builtin_amdgcn_permlane32_swap(__float_as_uint(mx), __float_as_uint(mx), false, false);
      mx = fmaxf(__uint_as_float(rr[0]), __uint_as_float(rr[1]));
    }
    if (first || __any(mx > 8.f)) {
      const float delta = (first || mx > 8.f) ? mx : 0.f;
      first = false;
      m_run += delta;
      const float alpha = ex2(-delta);
      l_run *= alpha;
#pragma unroll
      for (int i = 0; i < 16; ++i) minit[i] = -m_run;
#pragma unroll
      for (int t = 0; t < 2; ++t)
#pragma unroll
        for (int i = 0; i < 16; ++i) s[t][i] -= delta;
#pragma unroll
      for (int mt = 0; mt < NV; ++mt)
#pragma unroll
        for (int i = 0; i < 16; ++i) o[mt][i] *= alpha;
    }
    float psum = 0.f;
#pragma unroll
    for (int t = 0; t < 2; ++t)
#pragma unroll
      for (int i = 0; i < 16; ++i) {
        float pv = ex2(s[t][i]);
        s[t][i] = pv;
        psum += pv;
      }
    l_run += psum;
#pragma unroll
    for (int g = 0; g < 4; ++g) {
      if (g < 3) {
#pragma unroll
        for (int mt = 0; mt < NV; ++mt) vnxt[mt] = vread(g + 1, mt);
      }
      float tmp[8];
#pragma unroll
      for (int j = 0; j < 8; ++j) tmp[j] = s[g >> 1][8 * (g & 1) + j];
      bf16x8 pf = pack8(tmp);
#pragma unroll
      for (int mt = 0; mt < NV; ++mt) o[mt] = MFMA32(vcur[mt], pf, o[mt]);
#pragma unroll
      for (int mt = 0; mt < NV; ++mt) vcur[mt] = vnxt[mt];
    }
    if (more) lstore(buf ^ 1);
  }
}

DI void battn_item(const Params& p, int l, int b, int h, int qblk, int c, char* lds) {
  int tid_ = threadIdx.x;
  asm volatile("" : "+v"(tid_));
  const int tid = tid_, lane = tid & 63, wave = tid >> 6;
  const int r = lane & 31, hh = lane >> 5;
  const int q = qblk * 128 + wave * 32 + r;
  const size_t tok = (size_t)b * S + q;
  f32x16 o[4];
  bf16x8 qf[4];
#pragma unroll
  for (int ks = 0; ks < 4; ++ks) qf[ks] = *(const bf16x8*)(p.qb() + tok * 512 + h * 128 + c * 64 + ks * 16 + hh * 8);
#pragma unroll
  for (int mt = 0; mt < 4; ++mt) zero16(o[mt]);
  float m = 0.f, lsum = 0.f;
  attn_core<128, false>(o, m, lsum, qf, p.kb() + (size_t)b * S * 512 + h * 128 + c * 64, 512,
                        p.vbt() + (size_t)(b * 4 + h) * 128 * S, 0, 128, 0, lds, tid);
  lsum += __shfl_xor(lsum, 32);
  const float inv = 1.f / lsum;
  bf16_t* op = (c ? p.ob1() : p.ob0()) + tok * 512 + h * 128 + 4 * hh;
#pragma unroll
  for (int mt = 0; mt < 4; ++mt)
#pragma unroll
    for (int ig = 0; ig < 4; ++ig)
      *(u32x2*)(op + mt * 32 + 8 * ig) = pack4(o[mt][ig * 4 + 0] * inv, o[mt][ig * 4 + 1] * inv, o[mt][ig * 4 + 2] * inv,
                                               o[mt][ig * 4 + 3] * inv);
}

DI void aattn_item(const Params& p, int l, int b, int qblk, int h, char* lds) {
  int tid_ = threadIdx.x;
  asm volatile("" : "+v"(tid_));
  const int tid = tid_, lane = tid & 63, wave = tid >> 6;
  const int r = lane & 31, hh = lane >> 5;
  const int q = qblk * 128 + wave * 32 + r;
  const size_t tok = (size_t)b * S + q;
  const int kvh = h >> 2;
  bf16x8 qf[4];
#pragma unroll
  for (int ks = 0; ks < 4; ++ks) qf[ks] = *(const bf16x8*)(p.qa() + tok * 512 + h * 64 + ks * 16 + hh * 8);
  f32x16 o[2];
  zero16(o[0]);
  zero16(o[1]);
  float m = p.a_sink[l * 8 + h] * LOG2E;
  float lsum = hh == 0 ? 1.f : 0.f;
  const int kt0 = max(0, 2 * (qblk - 1)), kt1 = min(128, 2 * (qblk + 2));
  attn_core<64, true>(o, m, lsum, qf, p.ka() + (size_t)b * S * 128 + kvh * 64, 128, p.vat() + (size_t)(b * 2 + kvh) * 64 * S,
                      kt0, kt1, q, lds, tid);
  lsum += __shfl_xor(lsum, 32);
  const float inv = 1.f / lsum;
#pragma unroll
  for (int mt = 0; mt < 2; ++mt)
#pragma unroll
    for (int ig = 0; ig < 4; ++ig) {
      const int e0 = mt * 32 + 8 * ig + 4 * hh;
      u32x2 zz = *(const u32x2*)(p.za() + tok * 512 + h * 64 + e0);
      float y0 = o[mt][ig * 4 + 0] * inv * __uint_as_float(zz.x << 16);
      float y1 = o[mt][ig * 4 + 1] * inv * __uint_as_float(zz.x & 0xffff0000u);
      float y2 = o[mt][ig * 4 + 2] * inv * __uint_as_float(zz.y << 16);
      float y3 = o[mt][ig * 4 + 3] * inv * __uint_as_float(zz.y & 0xffff0000u);
      *(u32x2*)(p.oa() + tok * 512 + h * 64 + e0) = pack4(y0, y1, y2, y3);
    }
}

DI void c1_item(const Params& p, int l, int b, int h, int n, char* lds) {
  int tid_ = threadIdx.x;
  asm volatile("" : "+v"(tid_));
  const int tid = tid_, lane = tid & 63, wave = tid >> 6;
  const int r = lane & 31, hh = lane >> 5;
  bf16_t* q_rm = (bf16_t*)lds;
  bf16_t* k_rm = (bf16_t*)(lds + 17408);
  bf16_t* k_tr = (bf16_t*)(lds + 34816);
  bf16_t* v_tr = (bf16_t*)(lds + 53248);
  float* sm = (float*)(lds + 71680);
  float* Am = (float*)lds;
  const size_t tok0 = (size_t)b * S + n * 64;
  __syncthreads();
#pragma unroll 1
  for (int itb = 0; itb < 6; itb += 3) {
    float w[3][5], xin[3][20];
#pragma unroll
    for (int u = 0; u < 3; ++u) {
      const int idx = tid + 256 * (itb + u);
      const int ch = idx & 127, run = (idx >> 7) & 3, mm = idx >> 9;
      const int gcol = mm * 512 + h * 128 + ch;
#pragma unroll
      for (int tap = 0; tap < 5; ++tap) w[u][tap] = p.c_conv_w[(size_t)(l * 5 + tap) * 1536 + gcol];
#pragma unroll
      for (int jj = 0; jj < 20; ++jj) {
        int t = n * 64 + run * 16 - 2 + jj;
        xin[u][jj] = (t >= 0 && t < S) ? bf2f(p.cqkv()[((size_t)b * S + t) * 1536 + gcol]) : 0.f;
      }
    }
#pragma unroll
    for (int u = 0; u < 3; ++u) {
      const int idx = tid + 256 * (itb + u);
      const int ch = idx & 127, run = (idx >> 7) & 3, mm = idx >> 9;
      float y[16];
#pragma unroll
      for (int j = 0; j < 16; ++j) {
        float a = 0.f;
#pragma unroll
        for (int tap = 0; tap < 5; ++tap) a += w[u][tap] * xin[u][j + tap];
        y[j] = silu_f(a);
      }
      if (mm == 0) {
#pragma unroll
        for (int j = 0; j < 16; ++j) q_rm[(run * 16 + j) * 136 + ch] = f2bf(y[j]);
      } else {
        if (mm == 1) {
#pragma unroll
          for (int j = 0; j < 16; ++j) k_rm[(run * 16 + j) * 136 + ch] = f2bf(y[j]);
        }
        bf16_t* dst = (mm == 1 ? k_tr : v_tr) + ch * 72 + run * 16;
        *(bf16x8*)dst = pack8(y);
        *(bf16x8*)(dst + 8) = pack8(y + 8);
      }
    }
  }
  if (tid < 128) {
    const int dir = tid >> 6;
    const int c = dir ? 63 - lane : lane;
    const float* bg = p.betag() + (tok0 + c) * 16;
    float v = bg[8 + dir * 4 + h];
    const float be = bg[dir * 4 + h];
#pragma unroll
    for (int off = 1; off < 64; off <<= 1) {
      float t = __shfl_up(v, off);
      if (lane >= off) v += t;
    }
    sm[dir * 64 + c] = v;
    sm[128 + dir * 64 + c] = be;
  }
  __syncthreads();
  const int ti = wave >> 1, tj = wave & 1;
  f32x16 kk, qk, qq;
  zero16(kk);
  zero16(qk);
  zero16(qq);
#pragma unroll
  for (int ks = 0; ks < 8; ++ks) {
    bf16x8 ka_ = *(const bf16x8*)(k_rm + (ti * 32 + r) * 136 + ks * 16 + hh * 8);
    bf16x8 kb_ = *(const bf16x8*)(k_rm + (tj * 32 + r) * 136 + ks * 16 + hh * 8);
    bf16x8 qa_ = *(const bf16x8*)(q_rm + (ti * 32 + r) * 136 + ks * 16 + hh * 8);
    kk = MFMA32(ka_, kb_, kk);
    qk = MFMA32(qa_, kb_, qk);
    if (wave < 2) {
      bf16x8 qd_ = *(const bf16x8*)(q_rm + (wave * 32 + r) * 136 + ks * 16 + hh * 8);
      qq = MFMA32(qd_, qd_, qq);
    }
  }
  {
    float dk = 0.f, dq = 0.f;
#pragma unroll
    for (int i = 0; i < 16; ++i) {
      bool sel = (crow(i, hh) == r);
      dk = sel ? kk[i] : dk;
      dq = sel ? qq[i] : dq;
    }
    const bool own = (hh == ((r >> 2) & 1));
    if (own && ti == tj) sm[320 + ti * 32 + r] = rsqrtf(dk + 1e-6f);
    if (own && wave < 2) sm[256 + wave * 32 + r] = rsqrtf(dq + 1e-6f) * 0.08838834764831845f;
  }
  __syncthreads();
  const size_t item0 = (size_t)((b * 4 + h) * 2) * 128 + n, item1 = item0 + 128;
  {
    const int j = tj * 32 + r;
    const float rkj = sm[320 + j], g0j = sm[j], g1j = sm[64 + j];
#pragma unroll
    for (int i = 0; i < 16; ++i) {
      const int irow = ti * 32 + crow(i, hh);
      const float base = qk[i] * sm[256 + irow] * rkj;
      const float a0 = (j <= irow) ? base * __expf(sm[irow] - g0j) : 0.f;
      const float a1 = (j >= irow) ? base * __expf(sm[64 + irow] - g1j) : 0.f;
      p.c_attn()[item0 * 4096 + irow * 64 + j] = f2bf(a0);
      p.c_attn()[item1 * 4096 + irow * 64 + j] = f2bf(a1);
    }
  }
  {
    const float gl0 = sm[63], gl1 = sm[64];
#pragma unroll 1
    for (int dir = 0; dir < 2; ++dir) {
      const size_t item = dir ? item1 : item0;
      const float gl = dir ? gl1 : gl0;
#pragma unroll
      for (int it = 0; it < 4; ++it) {
        const int idx = tid + 256 * it;
        const int c = idx >> 4, dg = idx & 15;
        bf16x8 qv = *(const bf16x8*)(q_rm + c * 136 + dg * 8);
        const float sc = sm[256 + c] * __expf(sm[dir * 64 + c]);
        float t[8];
#pragma unroll
        for (int jj = 0; jj < 8; ++jj) t[jj] = bfs(qv[jj]) * sc;
        *(bf16x8*)(p.c_qd() + item * 8192 + c * 128 + dg * 8) = pack8(t);
      }
#pragma unroll
      for (int it = 0; it < 4; ++it) {
        const int idx = tid + 256 * it;
        const int d = idx >> 3, cg_ = idx & 7;
        bf16x8 kv = *(const bf16x8*)(k_tr + d * 72 + cg_ * 8);
        float t[8];
#pragma unroll
        for (int jj = 0; jj < 8; ++jj) {
          const int c = cg_ * 8 + jj;
          t[jj] = bfs(kv[jj]) * sm[320 + c] * __expf(gl - sm[dir * 64 + c]);
        }
        *(bf16x8*)(p.c_kt() + item * 8192 + d * 64 + cg_ * 8) = pack8(t);
      }
    }
    if (tid == 0) {
      p.c_egl()[item0] = __expf(gl0);
      p.c_egl()[item1] = __expf(gl1);
    }
  }
  __syncthreads();
  {
    const int j = tj * 32 + r;
    const float rkj = sm[320 + j], g0j = sm[j], g1j = sm[64 + j];
#pragma unroll
    for (int i = 0; i < 16; ++i) {
      const int irow = ti * 32 + crow(i, hh);
      const float base = kk[i] * sm[320 + irow] * rkj;
      const float a0 = (j < irow) ? base * sm[128 + irow] * __expf(sm[irow] - g0j) : 0.f;
      const float a1 = (j > irow) ? base * sm[192 + irow] * __expf(sm[64 + irow] - g1j) : 0.f;
      Am[irow * 65 + j] = a0;
      Am[4160 + irow * 65 + j] = a1;
    }
  }
  __syncthreads();
  {
    const int dir = wave >> 1, blk = wave & 1;
    float* T = Am + dir * 4160;
    const int base = 32 * blk;
    const int c = lane & 31;
    float* Tb = T + base * 65 + base + c;
    if (dir == 0) {
      for (int i = 0; i < 32; ++i) {
        const float a = Tb[i * 65];
        float sum = 0.f;
        for (int jb = 0; jb < i; jb += 16) {
#pragma unroll
          for (int jj = 0; jj < 16; ++jj) {
            const int j = jb + jj;
            const float aj = __int_as_float(__builtin_amdgcn_readlane(__float_as_int(a), j));
            sum = fmaf((j < i) ? aj : 0.f, Tb[j * 65], sum);
          }
        }
        Tb[i * 65] = (c == i ? 1.f : 0.f) - sum;
      }
    } else {
      for (int i = 31; i >= 0; --i) {
        const float a = Tb[i * 65];
        float sum = 0.f;
        for (int jb = (i + 1) & ~15; jb < 32; jb += 16) {
#pragma unroll
          for (int jj = 0; jj < 16; ++jj) {
            const int j = jb + jj;
            const float aj = __int_as_float(__builtin_amdgcn_readlane(__float_as_int(a), j));
            sum = fmaf((j > i) ? aj : 0.f, Tb[j * 65], sum);
          }
        }
        Tb[i * 65] = (c == i ? 1.f : 0.f) - sum;
      }
    }
    __syncthreads();
    if (blk == 0) {
      const int ar = dir == 0 ? 32 : 0, ac = dir == 0 ? 0 : 32;
      f32x16 X, Y;
      zero16(X);
      zero16(Y);
#pragma unroll
      for (int s = 0; s < 16; ++s) {
        const float a = T[(ar + r) * 65 + ac + 2 * s + hh];
        const float bq = T[(ac + 2 * s + hh) * 65 + ac + r];
        X = __builtin_amdgcn_mfma_f32_32x32x2f32(a, bq, X, 0, 0, 0);
      }
#pragma unroll
      for (int s = 0; s < 16; ++s) {
        const float a = T[(ar + r) * 65 + ar + crow(s, hh)];
        Y = __builtin_amdgcn_mfma_f32_32x32x2f32(a, X[s], Y, 0, 0, 0);
      }
#pragma unroll
      for (int i = 0; i < 16; ++i) T[(ar + crow(i, hh)) * 65 + ac + r] = -Y[i];
    }
  }
  __syncthreads();
  {
    const int dir = wave >> 1, which = wave & 1;
    const float* T = Am + dir * 4160;
    const bf16_t* Bsrc = which ? k_tr : v_tr;
    bf16_t* dst = (which ? p.c_w() : p.c_u()) + (dir ? item1 : item0) * 8192;
#pragma unroll 1
    for (int half = 0; half < 2; ++half) {
      f32x16 acc[2][2];
#pragma unroll
      for (int a = 0; a < 2; ++a)
#pragma unroll
        for (int bb = 0; bb < 2; ++bb) zero16(acc[a][bb]);
#pragma unroll
      for (int ks = 0; ks < 4; ++ks) {
        float cs[8];
#pragma unroll
        for (int jj = 0; jj < 8; ++jj) {
          const int j = ks * 16 + hh * 8 + jj;
          float c = sm[128 + dir * 64 + j];
          if (which) c *= sm[320 + j] * __expf(sm[dir * 64 + j]);
          cs[jj] = c;
        }
        bf16x8 af[2];
#pragma unroll
        for (int mt = 0; mt < 2; ++mt) {
          const float* tp = T + (mt * 32 + r) * 65 + ks * 16 + hh * 8;
          float t8[8];
#pragma unroll
          for (int jj = 0; jj < 8; ++jj) t8[jj] = tp[jj] * cs[jj];
          af[mt] = pack8(t8);
        }
#pragma unroll
        for (int nt = 0; nt < 2; ++nt) {
          bf16x8 bfr = *(const bf16x8*)(Bsrc + ((half * 2 + nt) * 32 + r) * 72 + ks * 16 + hh * 8);
#pragma unroll
          for (int mt = 0; mt < 2; ++mt) acc[mt][nt] = MFMA32(af[mt], bfr, acc[mt][nt]);
        }
      }
#pragma unroll
      for (int mt = 0; mt < 2; ++mt)
#pragma unroll
        for (int nt = 0; nt < 2; ++nt)
#pragma unroll
          for (int i = 0; i < 16; ++i) {
            const int c = mt * 32 + crow(i, hh), e = (half * 2 + nt) * 32 + r;
            dst[c * 128 + e] = f2bf(acc[mt][nt][i]);
          }
    }
  }
}

struct ScanRegs {
  bf16x8 wf[4], qf[4], af[2], kf[2][2];
  bf16_t u[2][4];
  float egl;
};

DI void c2_load(const Params& p, ScanRegs& R, size_t item, int sl, int wave, int l15, int q4) {
  const bf16_t* W = p.c_w() + item * 8192;
  const bf16_t* QD = p.c_qd() + item * 8192;
  const bf16_t* U = p.c_u() + item * 8192 + (16 * wave + q4 * 4) * 128 + sl * 32 + l15;
  const bf16_t* AT = p.c_attn() + item * 4096;
  const bf16_t* KT = p.c_kt() + item * 8192;
  R.egl = __hip_atomic_load(&p.c_egl()[item], __ATOMIC_RELAXED, __HIP_MEMORY_SCOPE_AGENT);
#pragma unroll
  for (int ks = 0; ks < 4; ++ks) {
    R.wf[ks] = *(const bf16x8*)(W + (16 * wave + l15) * 128 + ks * 32 + q4 * 8);
    R.qf[ks] = *(const bf16x8*)(QD + (16 * wave + l15) * 128 + ks * 32 + q4 * 8);
  }
#pragma unroll
  for (int ks = 0; ks < 2; ++ks) R.af[ks] = *(const bf16x8*)(AT + (16 * wave + l15) * 64 + ks * 32 + q4 * 8);
#pragma unroll
  for (int mt = 0; mt < 2; ++mt)
#pragma unroll
    for (int ks = 0; ks < 2; ++ks) R.kf[mt][ks] = *(const bf16x8*)(KT + (32 * wave + mt * 16 + l15) * 64 + ks * 32 + q4 * 8);
#pragma unroll
  for (int nt = 0; nt < 2; ++nt)
#pragma unroll
    for (int i = 0; i < 4; ++i) R.u[nt][i] = U[i * 128 + nt * 16];
}

DI void c2_item(const Params& p, int b, int h, int dir, int sl, char* lds) {
  int tid_ = threadIdx.x;
  asm volatile("" : "+v"(tid_));
  const int tid = tid_, lane = tid & 63, wave = tid >> 6;
  const int l15 = lane & 15, q4 = lane >> 4;
  __builtin_amdgcn_s_setprio(3);
  bf16_t* St = (bf16_t*)lds;
  bf16_t* VnT = (bf16_t*)(lds + 8704);
  __syncthreads();
  for (int i = tid; i < 32 * 136 / 2; i += 256) ((unsigned*)St)[i] = 0u;
  f32x4 sacc[2][2];
#pragma unroll
  for (int a = 0; a < 2; ++a)
#pragma unroll
    for (int bb = 0; bb < 2; ++bb) sacc[a][bb] = (f32x4){0.f, 0.f, 0.f, 0.f};
  __syncthreads();
  const size_t itembase = (size_t)((b * 4 + h) * 2 + dir) * 128;
  ScanRegs RA, RB;
  auto do_step = [&](const ScanRegs& cur, int step) {
    const int n = dir ? 127 - step : step;
    f32x4 av[2], ao[2];
#pragma unroll
    for (int nt = 0; nt < 2; ++nt) {
      av[nt] = (f32x4){0.f, 0.f, 0.f, 0.f};
      ao[nt] = (f32x4){0.f, 0.f, 0.f, 0.f};
    }
#pragma unroll
    for (int ks = 0; ks < 4; ++ks)
#pragma unroll
      for (int nt = 0; nt < 2; ++nt) {
        bf16x8 sf = *(const bf16x8*)(St + (nt * 16 + l15) * 136 + ks * 32 + q4 * 8);
        av[nt] = MFMA16(cur.wf[ks], sf, av[nt]);
        ao[nt] = MFMA16(cur.qf[ks], sf, ao[nt]);
      }
#pragma unroll
    for (int nt = 0; nt < 2; ++nt) {
      *(u32x2*)(VnT + (nt * 16 + l15) * 72 + 16 * wave + q4 * 4) =
          pack4(bf2f(cur.u[nt][0]) - av[nt][0], bf2f(cur.u[nt][1]) - av[nt][1], bf2f(cur.u[nt][2]) - av[nt][2], bf2f(cur.u[nt][3]) - av[nt][3]);
    }
    __syncthreads();
    bf16x8 vf[2][2];
#pragma unroll
    for (int nt = 0; nt < 2; ++nt)
#pragma unroll
      for (int ks = 0; ks < 2; ++ks) vf[nt][ks] = *(const bf16x8*)(VnT + (nt * 16 + l15) * 72 + ks * 32 + q4 * 8);
#pragma unroll
    for (int ks = 0; ks < 2; ++ks)
#pragma unroll
      for (int nt = 0; nt < 2; ++nt) ao[nt] = MFMA16(cur.af[ks], vf[nt][ks], ao[nt]);
    {
      bf16_t* op = p.oc() + ((size_t)dir * NTOK + (size_t)b * S + n * 64 + 16 * wave + q4 * 4) * 512 + h * 128 + sl * 32 + l15;
#pragma unroll
      for (int nt = 0; nt < 2; ++nt)
#pragma unroll
        for (int i = 0; i < 4; ++i) op[i * 512 + nt * 16] = f2bf(ao[nt][i]);
    }
#pragma unroll
    for (int mt = 0; mt < 2; ++mt)
#pragma unroll
      for (int nt = 0; nt < 2; ++nt) {
        sacc[mt][nt] *= cur.egl;
#pragma unroll
        for (int ks = 0; ks < 2; ++ks) sacc[mt][nt] = MFMA16(cur.kf[mt][ks], vf[nt][ks], sacc[mt][nt]);
        *(u32x2*)(St + (nt * 16 + l15) * 136 + 32 * wave + mt * 16 + q4 * 4) =
            pack4(sacc[mt][nt][0], sacc[mt][nt][1], sacc[mt][nt][2], sacc[mt][nt][3]);
      }
    __syncthreads();
  };
  c2_load(p, RA, itembase + (dir ? 127 : 0), sl, wave, l15, q4);
#pragma unroll 1
  for (int step = 0; step < 128; step += 2) {
    c2_load(p, RB, itembase + (dir ? 126 - step : step + 1), sl, wave, l15, q4);
    do_step(RA, step);
    if (step + 2 < 128) c2_load(p, RA, itembase + (dir ? 125 - step : step + 2), sl, wave, l15, q4);
    do_step(RB, step + 1);
  }
  __builtin_amdgcn_s_setprio(0);
}

DI void p3b_rows(const Params& p, int l) {
  int tid_ = threadIdx.x;
  asm volatile("" : "+v"(tid_));
  int nb_ = gridDim.x;
  asm volatile("" : "+s"(nb_));
  const int tid = tid_, lane = tid & 63, wave = tid >> 6;
  const float lam = p.lam()[l], lam_init = p.lam()[4 + l];
  for (int row = blockIdx.x * 4 + wave; row < NTOK; row += nb_ * 4) {
#pragma unroll
    for (int br = 0; br < 2; ++br) {
      bf16_t* X0 = br ? p.oc() : p.ob0();
      const bf16_t* X1 = br ? (p.oc() + (size_t)NTOK * 512) : p.ob1();
      const bf16_t* Z = br ? p.zc() : p.zb();
      const float c1 = br ? 1.f : -lam;
      const float fac = br ? 1.f : (1.f - lam_init);
      const float* gv = (br ? p.c_norm_g : p.b_subln_g) + l * 128 + (lane & 15) * 8;
      const size_t off = (size_t)row * 512 + lane * 8;
      bf16x8 f = *(const bf16x8*)(X0 + off);
      bf16x8 bw = *(const bf16x8*)(X1 + off);
      bf16x8 z = *(const bf16x8*)(Z + off);
      float v[8];
      float sq = 0.f;
#pragma unroll
      for (int j = 0; j < 8; ++j) {
        v[j] = bfs(f[j]) + c1 * bfs(bw[j]);
        sq += v[j] * v[j];
      }
      sq += __shfl_xor(sq, 1);
      sq += __shfl_xor(sq, 2);
      sq += __shfl_xor(sq, 4);
      sq += __shfl_xor(sq, 8);
      const float rs = rsqrtf(sq * (1.f / 128.f) + 1e-6f) * fac;
      float t[8];
#pragma unroll
      for (int j = 0; j < 8; ++j) t[j] = v[j] * rs * gv[j] * bfs(z[j]);
      *(bf16x8*)(X0 + off) = pack8(t);
    }
  }
}

DI void p4_tile(const Params& p, int l, int m, int n, char* lds) {
  int tid_ = threadIdx.x;
  asm volatile("" : "+v"(tid_));
  const int tid = tid_, lane = tid & 63, wave = tid >> 6;
  const int wm = wave >> 1, wn = wave & 1, r = lane & 31, hh = lane >> 5;
  const int row_base = m * 128 + wm * 64, col_base = n * 128 + wn * 64;
  f32x16 acc[2][2];
#pragma unroll
  for (int a = 0; a < 2; ++a)
#pragma unroll
    for (int b = 0; b < 2; ++b) zero16(acc[a][b]);
#pragma unroll 1
  for (int br = 0; br < 3; ++br) {
    const bf16_t* A = (br == 0 ? p.oa() : (br == 1 ? p.ob0() : p.oc())) + (size_t)m * 128 * 512;
    const bf16_t* B = p.wt_bo() + ((size_t)(l * 3 + br) * 1024 + n * 128) * 512;
    gemm_loop(
        acc, [&](int row, int k, int) { return *(const bf16x8*)(A + (size_t)row * 512 + k); },
        [&](int row, int k) { return *(const bf16x8*)(B + (size_t)row * 512 + k); }, 8, lds, tid);
    bf16_t* g0 = (bf16_t*)lds;
    bf16_t* g1 = (bf16_t*)(lds + 34816);
    __syncthreads();
    {
      const bf16_t* gsrc = p.gate() + (size_t)(m * 128) * 3072 + br * 1024 + n * 128;
#pragma unroll
      for (int j = 0; j < 8; ++j) {
        const int c = tid + 256 * j;
        const int rr = c >> 4, cc = c & 15;
        *(bf16x8*)(g0 + rr * 136 + cc * 8) = *(const bf16x8*)(gsrc + (size_t)rr * 3072 + cc * 8);
        if (br < 2) *(bf16x8*)(g1 + rr * 136 + cc * 8) = *(const bf16x8*)(gsrc + (size_t)rr * 3072 + 1024 + cc * 8);
      }
    }
    __syncthreads();
    const int lbase = (wm * 64 + 4 * hh) * 136 + wn * 64 + r;
    if (br < 2) {
#pragma unroll
      for (int mt = 0; mt < 2; ++mt)
#pragma unroll
        for (int i = 0; i < 16; ++i)
#pragma unroll
          for (int nt = 0; nt < 2; ++nt) {
            const int o = lbase + (mt * 32 + (i & 3) + 8 * (i >> 2)) * 136 + nt * 32;
            acc[mt][nt][i] *= bf2f(g0[o]) * frcp(fmaxf(bf2f(g1[o]), 1e-20f));
          }
    } else {
#pragma unroll
      for (int mt = 0; mt < 2; ++mt)
#pragma unroll
        for (int i = 0; i < 16; ++i)
#pragma unroll
          for (int nt = 0; nt < 2; ++nt) {
            const int o = lbase + (mt * 32 + (i & 3) + 8 * (i >> 2)) * 136 + nt * 32;
            g1[o] = f2bf(acc[mt][nt][i] * bf2f(g0[o]));
          }
      __syncthreads();
      bf16_t* dstp = p.merged() + (size_t)(m * 128) * 1024 + n * 128;
#pragma unroll
      for (int j = 0; j < 8; ++j) {
        const int c = tid + 256 * j;
        const int rr = c >> 4, cc = c & 15;
        *(bf16x8*)(dstp + (size_t)rr * 1024 + cc * 8) = *(const bf16x8*)(g1 + rr * 136 + cc * 8);
      }
    }
  }
}

DI void p5_tile(const Params& p, int l, int m, int n, char* lds) {
  int tid_ = threadIdx.x;
  asm volatile("" : "+v"(tid_));
  const int tid = tid_, lane = tid & 63, wave = tid >> 6;
  const int wm = wave >> 1, wn = wave & 1, r = lane & 31, hh = lane >> 5;
  const int row_base = m * 128 + wm * 64, col_base = n * 128 + wn * 64;
  f32x16 acc[2][2];
#pragma unroll
  for (int a = 0; a < 2; ++a)
#pragma unroll
    for (int b = 0; b < 2; ++b) zero16(acc[a][b]);
  const bf16_t* A = p.merged() + (size_t)m * 128 * 1024;
  const bf16_t* B = p.wt_out() + ((size_t)l * 1024 + n * 128) * 1024;
  gemm_loop(
      acc, [&](int row, int k, int) { return *(const bf16x8*)(A + (size_t)row * 1024 + k); },
      [&](int row, int k) { return *(const bf16x8*)(B + (size_t)row * 1024 + k); }, 16, lds, tid);
  const float* xsrc = (l == 0) ? p.x : p.out;
  float* ct = (float*)lds;
  __syncthreads();
#pragma unroll
  for (int mt = 0; mt < 2; ++mt)
#pragma unroll
    for (int i = 0; i < 16; ++i)
#pragma unroll
      for (int nt = 0; nt < 2; ++nt)
        ct[(wm * 64 + mt * 32 + crow(i, hh)) * 132 + wn * 64 + nt * 32 + r] = acc[mt][nt][i];
  __syncthreads();
#pragma unroll
  for (int j = 0; j < 16; ++j) {
    const int rr = (tid >> 5) + 8 * j, c4 = (tid & 31) * 4;
    const size_t g = (size_t)(m * 128 + rr) * 1024 + n * 128 + c4;
    const float4 a = *(const float4*)(ct + rr * 132 + c4);
    float4 x = *(const float4*)(xsrc + g);
    x.x += a.x;
    x.y += a.y;
    x.z += a.z;
    x.w += a.w;
    *(float4*)(p.out + g) = x;
    *(u32x2*)(p.xb() + g) = pack4(x.x, x.y, x.z, x.w);
    float ss = x.x * x.x + x.y * x.y + x.z * x.z + x.w * x.w;
    ss += __shfl_xor(ss, 16);
    ss += __shfl_xor(ss, 8);
    ss += __shfl_xor(ss, 4);
    ss += __shfl_xor(ss, 2);
    ss += __shfl_xor(ss, 1);
    if ((tid & 31) == 0) atomicAdd(&p.rowss()[(size_t)(l + 1) * NTOK + m * 128 + rr], ss);
  }
}

DI void phase_final(const Params& p) {
  const size_t n4 = (size_t)NTOK * 256;
  int tid_ = threadIdx.x;
  asm volatile("" : "+v"(tid_));
  int nb_ = gridDim.x;
  asm volatile("" : "+s"(nb_));
  for (size_t i = (size_t)blockIdx.x * 256 + tid_; i < n4; i += (size_t)nb_ * 256) {
    const int row = (int)(i >> 8), c4 = (int)(i & 255);
    const float rs = rsqrtf(p.rowss()[(size_t)4 * NTOK + row] * (1.f / 1024.f) + 1e-6f);
    float4 v = ((const float4*)p.out)[i];
    const float4 g = ((const float4*)p.final_g)[c4];
    v.x *= rs * g.x;
    v.y *= rs * g.y;
    v.z *= rs * g.z;
    v.w *= rs * g.w;
    ((float4*)p.out)[i] = v;
  }
}


#define XB_XCNT(j) (64 * (j))
#define XB_XSUB(j) (1024 + 64 * (j))
#define XB_XGEN(j) (2048 + 64 * (j))
#define XB_TOP 3072
#define XB_TOPGEN 3136
#define XB_FLAT 3264
#define XB_WORDS 3328
DI unsigned xb_ld(unsigned* q) { return __hip_atomic_load(q, __ATOMIC_RELAXED, __HIP_MEMORY_SCOPE_AGENT); }
DI unsigned xb_add(unsigned* q, unsigned v) { return __hip_atomic_fetch_add(q, v, __ATOMIC_RELAXED, __HIP_MEMORY_SCOPE_AGENT); }
DI unsigned xcc_id() { return (unsigned)__builtin_amdgcn_s_getreg((3 << 11) | 20) & 0xFu; }
#define XB_SPIN(cond)                                   \
  do {                                                  \
    unsigned sp_ = 0;                                   \
    while (cond) {                                      \
      __builtin_amdgcn_s_sleep(1);                      \
      if (++sp_ > (1u << 24)) break;                    \
    }                                                   \
  } while (0)

#define LAS __attribute__((address_space(3)))
DI void gbar(unsigned* bar, volatile LAS unsigned* st) {
  asm volatile("s_waitcnt vmcnt(0)" ::: "memory");
  __syncthreads();
  if (threadIdx.x == 0) {
    __builtin_amdgcn_s_waitcnt(0);
    const unsigned nloc = st[0], nx = st[1], x = st[2];
    const unsigned old = xb_add(&bar[XB_XSUB(x)], 1u);
    const unsigned gen = old / nloc;
    if (old + 1u == (gen + 1u) * nloc) {
      __builtin_amdgcn_fence(__ATOMIC_RELEASE, "agent");
      asm volatile("s_waitcnt vmcnt(0)" ::: "memory");
      xb_add(&bar[XB_TOP], 1u);
    }
    XB_SPIN(xb_ld(&bar[XB_TOP]) < (gen + 1u) * nx);
    __builtin_amdgcn_fence(__ATOMIC_ACQUIRE, "agent");
    asm volatile("s_waitcnt vmcnt(0)" ::: "memory");
  }
  __syncthreads();
}

DI int next_item(unsigned* ctr, int n_per_q, int& qoff, unsigned xcc, volatile LAS int* s_item) {
  __syncthreads();
  if (threadIdx.x == 0) {
    int res = -1;
    while (qoff < 8) {
      const int q = (int)((xcc + (unsigned)qoff) & 7u);
      const int it = (int)atomicAdd(ctr + q * 16, 1u);
      if (it < n_per_q) {
        res = q * n_per_q + it;
        break;
      }
      ++qoff;
    }
    *s_item = res;
  }
  __syncthreads();
  return *s_item;
}

__global__ void __launch_bounds__(256, 2) mega(Params p) {
  __shared__ __attribute__((aligned(16))) char lds[LDS_TOTAL];
  __shared__ unsigned xst_s[4];
  __shared__ int s_item_s[4];
  volatile LAS unsigned* xst = (volatile LAS unsigned*)&xst_s[0];
  volatile LAS int* s_item = (volatile LAS int*)&s_item_s[0];
  cg::grid_group grid = cg::this_grid();
  const int bid = blockIdx.x, nb = gridDim.x;
  if (threadIdx.x == 0) {
    const unsigned x = xcc_id();
    xst[2] = x;
    xb_add(&p.bar()[XB_XCNT(x)], 1u);
  }
  for (int ph = p.ph0; ph < p.ph1; ++ph) {
    if (ph == 0) {
      if (PH_MASK & 1) phase0(p, lds);
    } else if (ph == N_PHASES - 1) {
      phase_final(p);
    } else {
      const int l = (ph - 1) / SLOTS, slot = (ph - 1) % SLOTS;
      int k = slot, cofs = 0, flags = 3;
      if (SLOTS == 7) {
        const int d = p.dup_k;
        if (d < 0) k = (slot < 6) ? slot : 99;
        else if (slot == d + 1) { k = d; cofs = 8; flags = p.dup_flags; }
        else if (slot > d + 1) k = slot - 1;
      }
      if (k == 0) {
        const int xc = bid & 7, cnt = (nb - xc + 7) >> 3;
        for (int j = bid >> 3; j < 9 * 128; j += cnt) {
          const int ng = j >> 7, r7 = j & 127;
          const int m = 16 * xc + 8 * (r7 >> 6) + (r7 & 7), n = 8 * ng + ((r7 & 63) >> 3);
          if (n < 67 && (PH_MASK & 2)) p1_tile(p, l, m, n, lds);
        }
      } else if (k == 1) {
        unsigned* ctr = p.qctr() + (l * 2 + cofs) * 128;
        const unsigned xcc = xst[2];
        int qoff = 0;
        for (;;) {
          const int it = next_item(ctr, 256, qoff, xcc, s_item);
          if (it < 0) break;
          const int q = it >> 8, i = it & 255;
          if (i < 128) {
            if (flags & 1) c1_item(p, l, q >> 2, q & 3, i, lds);
          } else {
            const int j = i - 128;
            if (flags & 2) aattn_item(p, l, q >> 2, (q & 1) * 32 + (j >> 2), ((q >> 1) & 1) * 4 + (j & 3), lds);
          }
        }
      } else if (k == 2) {
        unsigned* ctr = p.qctr() + (l * 2 + 1 + cofs) * 128;
        const unsigned xcc = xst[2];
        int qoff = 0;
        for (;;) {
          const int it = next_item(ctr, 136, qoff, xcc, s_item);
          if (it < 0) break;
          const int q = it / 136, i = it % 136;
          if (i < 8) {
            if (flags & 1) c2_item(p, q >> 2, q & 3, (i >> 2) & 1, i & 3, lds);
          } else {
            const int j = i - 8;
            if (flags & 2) battn_item(p, l, q >> 2, q & 3, j >> 1, j & 1, lds);
          }
        }
      } else if (k == 3) {
        if (PH_MASK & 64) p3b_rows(p, l);
      } else if (k == 4) {
        const int xc = bid & 7, cnt = (nb - xc + 7) >> 3;
        for (int j = bid >> 3; j < 128; j += cnt) if (PH_MASK & 64) p4_tile(p, l, 16 * xc + (j >> 3), j & 7, lds);
      } else if (k == 5) {
        const int xc = bid & 7, cnt = (nb - xc + 7) >> 3;
        for (int j = bid >> 3; j < 128; j += cnt) if (PH_MASK & 128) p5_tile(p, l, 16 * xc + (j >> 3), j & 7, lds);
      }
    }
    if (ph + 1 < p.ph1) {
      if (ph == p.ph0) {
        if (p.ph1 > 100000) grid.sync();
        asm volatile("s_waitcnt vmcnt(0)" ::: "memory");
        __syncthreads();
        if (threadIdx.x == 0) {
          __builtin_amdgcn_fence(__ATOMIC_RELEASE, "agent");
          asm volatile("s_waitcnt vmcnt(0)" ::: "memory");
          xb_add(&p.bar()[XB_FLAT], 1u);
          XB_SPIN(xb_ld(&p.bar()[XB_FLAT]) < (unsigned)nb);
          __builtin_amdgcn_fence(__ATOMIC_ACQUIRE, "agent");
          asm volatile("s_waitcnt vmcnt(0)" ::: "memory");
        }
        if (threadIdx.x == 0) {
          unsigned cnt = 0, mine = 0;
          const unsigned x = xst[2];
          for (unsigned j = 0; j < 16; ++j) {
            const unsigned c = xb_ld(&p.bar()[XB_XCNT(j)]);
            cnt += (c > 0u) ? 1u : 0u;
            mine = (j == x) ? c : mine;
          }
          xst[0] = mine > 0u ? mine : 1u;
          xst[1] = cnt > 0u ? cnt : 1u;
        }
        __syncthreads();
      } else {
        gbar(p.bar(), xst);
      }
    }
  }
}

extern "C" void kernel_launch(void* const* d_in, const int* in_sizes, int n_in, void* d_out, int out_size, void* d_ws,
                              size_t ws_size, hipStream_t stream) {
  static int grid_blocks = 0;
  if (!grid_blocks) {
    int dev = 0, cus = 0, per_cu = 0;
    hipGetDevice(&dev);
    hipDeviceGetAttribute(&cus, hipDeviceAttributeMultiprocessorCount, dev);
    hipOccupancyMaxActiveBlocksPerMultiprocessor(&per_cu, mega, 256, 0);
    if (per_cu > 2) per_cu = 2;
    if (per_cu < 1) per_cu = 1;
    grid_blocks = cus * per_cu;
  }
  Params p{};
  p.x = (const float*)d_in[0];
  p.norm_g = (const float*)d_in[1];
  p.w_in = (const float*)d_in[2];
  p.a_sink = (const float*)d_in[3];
  p.b_lambda = (const float*)d_in[4];
  p.b_subln_g = (const float*)d_in[5];
  p.c_conv_w = (const float*)d_in[6];
  p.c_a_log = (const float*)d_in[7];
  p.c_dt_bias = (const float*)d_in[8];
  p.c_norm_g = (const float*)d_in[9];
  p.w_bo_a = (const float*)d_in[10];
  p.w_bo_b = (const float*)d_in[11];
  p.w_bo_c = (const float*)d_in[12];
  p.w_out = (const float*)d_in[13];
  p.final_g = (const float*)d_in[14];
  p.out = (float*)d_out;

  p.ws = (char*)d_ws;
  if (grid_blocks > MAX_GRID) grid_blocks = MAX_GRID;
  if (WS_TOTAL > ws_size) fprintf(stderr, "workspace too small: need %zu have %zu\n", (size_t)WS_TOTAL, ws_size);
  p.ph0 = 0;
  p.ph1 = N_PHASES;
  p.dup_k = DUP_K;
  p.dup_flags = DUP_FLAGS;
  hipMemsetAsync((char*)d_ws + OFF_BAR, 0, 32768, stream);
  void* args[] = {&p};
  hipError_t e = hipLaunchCooperativeKernel((void*)mega, dim3(grid_blocks), dim3(256), args, 0, stream);
  if (e != hipSuccess) fprintf(stderr, "cooperative launch failed: %s (grid %d)\n", hipGetErrorString(e), grid_blocks);
}
```
